# Optimizing an MI355X kernel written in HIP

```python
import math
import jax, jax.numpy as jnp
from jax import lax
import numpy as np

D_MODEL = 1024
BATCH = 8
SEQ = 4096
DEPTH = 2

HEAD_DIM = 64
FOX_HEADS = (3 * D_MODEL) // (8 * HEAD_DIM)
FOX_WIDTH = FOX_HEADS * HEAD_DIM
DIFF_QK_DIM = 32
DIFF_V_DIM = 2 * DIFF_QK_DIM
DIFF_HEADS = D_MODEL // (4 * DIFF_V_DIM)
DIFF_WIDTH = DIFF_HEADS * DIFF_V_DIM
SGU_HEAD_DIM = 64
SGU_WIDTH = D_MODEL - FOX_WIDTH - DIFF_WIDTH
SGU_HEADS = SGU_WIDTH // SGU_HEAD_DIM
CHUNK = 128
Q_BLOCK = 128
IN_COLS = 3 * FOX_WIDTH + FOX_HEADS + 3 * DIFF_WIDTH + 2 * SGU_WIDTH
D_FF = 2816
ALPHA = (2 * DEPTH) ** 0.25
BETA = (8 * DEPTH) ** -0.25
LN_EPS = 1e-5
NEG_INF = -1e30

kernel_name = 'hybrid_fox_diff_sgu_macaron_deepnorm'


def _layer_norm(x, g, b):
    xf = x.astype(jnp.float32)
    mu = jnp.mean(xf, axis=-1, keepdims=True)
    var = jnp.mean(jnp.square(xf - mu), axis=-1, keepdims=True)
    return ((xf - mu) * lax.rsqrt(var + LN_EPS)).astype(x.dtype) * g + b


def _swiglu(x, w_gate, w_up, w_down):
    return (jax.nn.silu(x @ w_gate) * (x @ w_up)) @ w_down


def _to_blocks(a):
    b, s = a.shape[0], a.shape[1]
    a = a.reshape((b, s // Q_BLOCK, Q_BLOCK) + a.shape[2:])
    return jnp.moveaxis(a, 1, 0)


def _from_blocks(a):
    a = jnp.moveaxis(a, 0, 1)
    return a.reshape((a.shape[0], a.shape[1] * a.shape[2]) + a.shape[3:])


def _forgetting_attention(q, k, v, log_f):
    seq = q.shape[1]
    scale = HEAD_DIM ** -0.5
    c = jnp.cumsum(log_f, axis=1)
    c_k = jnp.transpose(c, (0, 2, 1))
    k_pos = jnp.arange(seq)

    def block(args):
        q_blk, c_blk, i = args
        q_pos = i * Q_BLOCK + jnp.arange(Q_BLOCK)
        s = jnp.einsum('bqhd,bkhd->bhqk', q_blk, k, preferred_element_type=jnp.float32) * scale
        s = s + jnp.transpose(c_blk, (0, 2, 1))[..., None] - c_k[:, :, None, :]
        s = jnp.where(k_pos[None, :] <= q_pos[:, None], s, NEG_INF)
        p = jax.nn.softmax(s, axis=-1).astype(v.dtype)
        return jnp.einsum('bhqk,bkhd->bqhd', p, v)

    nb = seq // Q_BLOCK
    out = lax.map(block, (_to_blocks(q), _to_blocks(c), jnp.arange(nb)))
    return _from_blocks(out)


def _diff_attention(q, k, v, lam, lam_init, norm_g):
    seq = q.shape[1]
    scale = DIFF_QK_DIM ** -0.5
    slopes = 2.0 ** (-8.0 * jnp.arange(1, DIFF_HEADS + 1, dtype=jnp.float32) / DIFF_HEADS)
    k_pos = jnp.arange(seq)

    def block(args):
        q_blk, i = args
        q_pos = i * Q_BLOCK + jnp.arange(Q_BLOCK)
        dist = (q_pos[:, None] - k_pos[None, :]).astype(jnp.float32)
        s = jnp.einsum('bqhmd,bkhmd->bhmqk', q_blk, k, preferred_element_type=jnp.float32) * scale
        s = s - slopes[None, :, None, None, None] * dist[None, None, None]
        s = jnp.where(dist >= 0, s, NEG_INF)
        p = jax.nn.softmax(s, axis=-1)
        a = (p[:, :, 0] - lam * p[:, :, 1]).astype(v.dtype)
        return jnp.einsum('bhqk,bkhe->bqhe', a, v)

    nb = seq // Q_BLOCK
    o = _from_blocks(lax.map(block, (_to_blocks(q), jnp.arange(nb))))
    of = o.astype(jnp.float32)
    o = (of * lax.rsqrt(jnp.mean(jnp.square(of), axis=-1, keepdims=True) + LN_EPS)).astype(v.dtype)
    o = o * norm_g.reshape(DIFF_HEADS, DIFF_V_DIM)
    return o * (1.0 - lam_init)


def _chunked_spatial_gating(z, ln_g, ln_b, w_s, b_s):
    u, g = jnp.split(z, 2, axis=-1)
    g = _layer_norm(g, ln_g, ln_b)
    b, s, _ = g.shape
    g = g.reshape(b, s // CHUNK, CHUNK, SGU_HEADS, SGU_HEAD_DIM)
    w = jnp.tril(w_s)
    mixed = jnp.einsum('hts,bcshd->bcthd', w, g) + jnp.transpose(b_s)[None, None, :, :, None]
    return u * mixed.reshape(b, s, SGU_WIDTH)


def _hybrid_mixer(x, w_in, f_bias, lq1, lk1, lq2, lk2, lam_init, diff_norm_g,
                  sgu_ln_g, sgu_ln_b, sgu_w_s, sgu_b_s, w_out):
    b, s, _ = x.shape
    proj = x @ w_in
    i1 = 3 * FOX_WIDTH
    i2 = i1 + FOX_HEADS
    i3 = i2 + 3 * DIFF_WIDTH
    fox_qkv, fox_f, diff_qkv, sgu_z = jnp.split(proj, [i1, i2, i3], axis=-1)
    fq, fk, fv = [t.reshape(b, s, FOX_HEADS, HEAD_DIM) for t in jnp.split(fox_qkv, 3, axis=-1)]
    log_f = jax.nn.log_sigmoid(fox_f.astype(jnp.float32) + f_bias.astype(jnp.float32))
    y_fox = _forgetting_attention(fq, fk, fv, log_f).reshape(b, s, FOX_WIDTH)
    dq, dk, dv = jnp.split(diff_qkv, 3, axis=-1)
    dq = dq.reshape(b, s, DIFF_HEADS, 2, DIFF_QK_DIM)
    dk = dk.reshape(b, s, DIFF_HEADS, 2, DIFF_QK_DIM)
    dv = dv.reshape(b, s, DIFF_HEADS, DIFF_V_DIM)
    lam = (jnp.exp(jnp.sum(lq1.astype(jnp.float32) * lk1.astype(jnp.float32)))
           - jnp.exp(jnp.sum(lq2.astype(jnp.float32) * lk2.astype(jnp.float32))) + lam_init)
    y_diff = _diff_attention(dq, dk, dv, lam, lam_init, diff_norm_g).reshape(b, s, DIFF_WIDTH)
    y_sgu = _chunked_spatial_gating(jax.nn.gelu(sgu_z), sgu_ln_g, sgu_ln_b, sgu_w_s, sgu_b_s)
    return jnp.concatenate([y_fox, y_diff, y_sgu], axis=-1) @ w_out


def setup_inputs(seed: int = 0) -> dict:
    key = jax.random.key(seed)
    ks = jax.random.split(key, 32)
    L, D, F = DEPTH, D_MODEL, D_FF

    def nrm(k, shape, scale):
        return jax.random.normal(k, shape, jnp.float32) * scale

    def gain(k, shape):
        return 1.0 + nrm(k, shape, 0.02)

    return {
        'x': nrm(ks[0], (BATCH, SEQ, D), 1.0),
        'ffn_a_w_gate': nrm(ks[1], (L, D, F), D ** -0.5),
        'ffn_a_w_up': nrm(ks[2], (L, D, F), D ** -0.5),
        'ffn_a_w_down': nrm(ks[3], (L, F, D), BETA * F ** -0.5),
        'norm_a_g': gain(ks[4], (L, D)),
        'norm_a_b': nrm(ks[5], (L, D), 0.02),
        'w_in': nrm(ks[6], (L, D, IN_COLS), D ** -0.5),
        'fox_f_bias': jax.random.uniform(ks[7], (L, FOX_HEADS), jnp.float32, 1.0, 4.0),
        'diff_lambda_q1': nrm(ks[8], (L, DIFF_QK_DIM), 0.1),
        'diff_lambda_k1': nrm(ks[9], (L, DIFF_QK_DIM), 0.1),
        'diff_lambda_q2': nrm(ks[10], (L, DIFF_QK_DIM), 0.1),
        'diff_lambda_k2': nrm(ks[11], (L, DIFF_QK_DIM), 0.1),
        'diff_norm_g': gain(ks[12], (L, DIFF_WIDTH)),
        'sgu_norm_g': gain(ks[13], (L, SGU_WIDTH)),
        'sgu_norm_b': nrm(ks[14], (L, SGU_WIDTH), 0.02),
        'sgu_w_s': nrm(ks[15], (L, SGU_HEADS, CHUNK, CHUNK), CHUNK ** -0.5),
        'sgu_b_s': 1.0 + nrm(ks[16], (L, SGU_HEADS, CHUNK), 0.1),
        'w_out': nrm(ks[17], (L, D, D), BETA * D ** -0.5),
        'norm_m_g': gain(ks[18], (L, D)),
        'norm_m_b': nrm(ks[19], (L, D), 0.02),
        'ffn_b_w_gate': nrm(ks[20], (L, D, F), D ** -0.5),
        'ffn_b_w_up': nrm(ks[21], (L, D, F), D ** -0.5),
        'ffn_b_w_down': nrm(ks[22], (L, F, D), BETA * F ** -0.5),
        'norm_b_g': gain(ks[23], (L, D)),
        'norm_b_b': nrm(ks[24], (L, D), 0.02),
    }


def reference(x, ffn_a_w_gate, ffn_a_w_up, ffn_a_w_down, norm_a_g, norm_a_b,
              w_in, fox_f_bias, diff_lambda_q1, diff_lambda_k1, diff_lambda_q2, diff_lambda_k2,
              diff_norm_g, sgu_norm_g, sgu_norm_b, sgu_w_s, sgu_b_s, w_out, norm_m_g, norm_m_b,
              ffn_b_w_gate, ffn_b_w_up, ffn_b_w_down, norm_b_g, norm_b_b):
    h = x
    for l in range(DEPTH):
        lam_init = 0.8 - 0.6 * math.exp(-0.3 * l)
        h = _layer_norm(ALPHA * h + 0.5 * _swiglu(h, ffn_a_w_gate[l], ffn_a_w_up[l], ffn_a_w_down[l]),
                        norm_a_g[l], norm_a_b[l])
        m = _hybrid_mixer(h, w_in[l], fox_f_bias[l], diff_lambda_q1[l], diff_lambda_k1[l],
                          diff_lambda_q2[l], diff_lambda_k2[l], lam_init, diff_norm_g[l],
                          sgu_norm_g[l], sgu_norm_b[l], sgu_w_s[l], sgu_b_s[l], w_out[l])
        h = _layer_norm(ALPHA * h + m, norm_m_g[l], norm_m_b[l])
        h = _layer_norm(ALPHA * h + 0.5 * _swiglu(h, ffn_b_w_gate[l], ffn_b_w_up[l], ffn_b_w_down[l]),
                        norm_b_g[l], norm_b_b[l])
    return h
```

```cpp
#include <hip/hip_runtime.h>
#include <hip/hip_cooperative_groups.h>
#include <cstdio>
#include <cstdint>
namespace cg = cooperative_groups;
namespace pg8 {
#define PG8_LAS __attribute__((address_space(3)))
typedef unsigned short bf16_t;
typedef short bf16x8 __attribute__((ext_vector_type(8)));
typedef float f32x4 __attribute__((ext_vector_type(4)));
typedef unsigned u32x4 __attribute__((ext_vector_type(4)));
constexpr int BM = 256, BK = 64, HALF = 128, HTB = HALF * BK * 2  , STAGE_BYTES = 8 * HTB, NXCD = 8, WGM = 8;

__host__ __device__ __forceinline__ int lds_byte(int r, int c) { const int st = (r >> 4) * 2 + (c >> 5), rr = r & 15, cc = c & 31, ob = rr * 64 + cc * 2; return st * 1024 + (ob ^ (((ob >> 9) & 1) << 5)); }
__host__ __device__ __forceinline__ void stage_rc(int b, int& R, int& C) { const int st = b / 1024, sb = b % 1024, swz = sb ^ (((sb >> 9) & 1) << 5); R = (st >> 1) * 16 + swz / 64; C = (st & 1) * 32 + (swz % 64) / 2; }
__host__ __device__ __forceinline__ int perm32(int rho) { const int n = rho >> 4, i = rho & 15; return 8 * (i >> 2) + 4 * n + (i & 3); }

struct Unit { int pm, pn; };
struct Gemm { const bf16_t* A; const bf16_t* Bt; int M, N, K; };

struct StaticOrder {
    int nM, nN, nwg, G, c;
    __host__ __device__ void init(int M, int N, int G_, int c_) { nM = M / BM; nN = N / BM; nwg = nM * nN; G = G_; c = c_; }
    __host__ __device__ bool next(int i, Unit& u) const {
        const long L = (long)i * G + c; if (L >= nwg) return false;
        int wgid = (int)L; { const int q = nwg / NXCD, r = nwg % NXCD, xcd = wgid % NXCD, off = wgid / NXCD; wgid = (xcd < r ? xcd * (q + 1) : r * (q + 1) + (xcd - r) * q) + off; }
        const int nig = WGM * nN, gid = wgid / nig, fm = gid * WGM, gsz = (nM - fm) < WGM ? (nM - fm) : WGM;
        u.pm = fm + ((wgid % nig) % gsz); u.pn = (wgid % nig) / gsz; return true;
    }
    __device__ __forceinline__ void a_ready(const Unit&) const {}
    __device__ __forceinline__ void done(const Unit&) const {}
};
__device__ __forceinline__ unsigned cvt_pk_bf16(float lo, float hi) { unsigned r; asm volatile("v_cvt_pk_bf16_f32 %0, %1, %2" : "=v"(r) : "v"(lo), "v"(hi)); return r; }
typedef float f32x2 __attribute__((ext_vector_type(2)));
template <class Epi, class Sched, bool ALIGN_EPI = false, bool SP2 = false>
__device__ __forceinline__ void gemm_phase(PG8_LAS unsigned char* lds, const Gemm g, const Sched& S, const Epi& E) {
    int tid_ = threadIdx.x; asm volatile("" : "+v"(tid_));
    const int tid = tid_, wid = __builtin_amdgcn_readfirstlane(tid >> 6), lane = tid & 63, wr = wid >> 2, wc = wid & 3, fr = lane & 15, fq = lane >> 4;
    const int K = g.K, nt = K / BK;
    unsigned voffA[2], voffB[2];
#pragma unroll
    for (int i = 0; i < 2; ++i) { int R, C; stage_rc(tid * 16 + i * 8192, R, C); const int Rb = Epi::PERM ? ((R & ~31) + perm32(R & 31)) : R;
        voffA[i] = (unsigned)(R * K + C) * 2u; voffB[i] = (unsigned)(Rb * K + C) * 2u; }
    const size_t kstep = (size_t)(BK * 2);
    const size_t hstep = (size_t)HALF * K * 2;
    const size_t tstep = 2 * hstep;
    const unsigned ldsw = (unsigned)wid * 1024u;
    const int aoff = lds_byte(wr * 64 + fr, fq * 8), boff = lds_byte(wc * 32 + fr, fq * 8);
#define PG8_SA(b, h) (((b) * 2 + (h)) * HTB)
#define PG8_SB(b, h) ((4 + (b) * 2 + (h)) * HTB)
#define PG8_STAGE(bufoff, gbase, voff) do { _Pragma("unroll") for (int _i = 0; _i < 2; ++_i) \
        __builtin_amdgcn_global_load_lds((const unsigned*)((const char*)(gbase) + (voff)[_i]), (PG8_LAS unsigned*)(lds + (bufoff) + ldsw + _i * 8192), 16, 0, 0); } while (0)
#define PG8_LDA(dst, b, h) do { _Pragma("unroll") for (int m = 0; m < 4; ++m) _Pragma("unroll") for (int k = 0; k < 2; ++k) dst[m][k] = *(const PG8_LAS bf16x8*)(lds + PG8_SA(b, h) + aoff + m * 2048 + k * 1024); } while (0)
#define PG8_LDB(dst, b, h) do { _Pragma("unroll") for (int n = 0; n < 2; ++n) _Pragma("unroll") for (int k = 0; k < 2; ++k) dst[n][k] = *(const PG8_LAS bf16x8*)(lds + PG8_SB(b, h) + boff + n * 2048 + k * 1024); } while (0)
#define PG8_MMA(ai, bj, At, Bt) do { __builtin_amdgcn_s_setprio(1); _Pragma("unroll") for (int m = 0; m < 4; ++m) _Pragma("unroll") for (int n = 0; n < 2; ++n) _Pragma("unroll") for (int k = 0; k < 2; ++k) \
        acc[ai][bj][m][n] = __builtin_amdgcn_mfma_f32_16x16x32_bf16(Bt[n][k], At[m][k], acc[ai][bj][m][n], 0, 0, 0); __builtin_amdgcn_s_setprio(0); } while (0)
#define PG8_WAIT_V(n) asm volatile("s_waitcnt vmcnt(" #n ")" ::: "memory")
#define PG8_WAIT_L(n) asm volatile("s_waitcnt lgkmcnt(" #n ")" ::: "memory")
#define PG8_BAR __builtin_amdgcn_s_barrier()
#define PG8_SCHED __builtin_amdgcn_sched_barrier(0)
    Unit cur, nxt; int ui = 0;
    if (!S.next(0, cur)) return;
    f32x4 acc[2][2][4][2];
#pragma unroll
    for (int a = 0; a < 2; ++a)
#pragma unroll
        for (int b = 0; b < 2; ++b)
#pragma unroll
            for (int m = 0; m < 4; ++m)
#pragma unroll
                for (int n = 0; n < 2; ++n) acc[a][b][m][n] = (f32x4){0.f, 0.f, 0.f, 0.f};
    bf16x8 At[4][2], B0[2][2], B1[2][2];
    const char* cA = (const char*)g.A + (size_t)cur.pm * tstep; const char* cB = (const char*)g.Bt + (size_t)cur.pn * tstep;
    S.a_ready(cur);
    if constexpr (SP2) {
        PG8_STAGE(PG8_SB(0, 0), cB, voffB); PG8_STAGE(PG8_SB(0, 1), cB + hstep, voffB); PG8_STAGE(PG8_SA(0, 0), cA, voffA); PG8_STAGE(PG8_SA(0, 1), cA + hstep, voffA);
        if (wr == 1) PG8_BAR;
        PG8_WAIT_V(2); PG8_BAR;
        PG8_STAGE(PG8_SB(1, 0), cB + kstep, voffB); PG8_STAGE(PG8_SA(1, 0), cA + kstep, voffA); PG8_STAGE(PG8_SB(1, 1), cB + hstep + kstep, voffB);
        PG8_WAIT_V(6); PG8_BAR;
    } else {
        PG8_STAGE(PG8_SB(0, 0), cB, voffB); PG8_STAGE(PG8_SA(0, 0), cA, voffA); PG8_STAGE(PG8_SB(0, 1), cB + hstep, voffB); PG8_STAGE(PG8_SA(0, 1), cA + hstep, voffA);
        if (wr == 1) PG8_BAR;
        PG8_WAIT_V(4); PG8_BAR;
        PG8_STAGE(PG8_SB(1, 0), cB + kstep, voffB); PG8_STAGE(PG8_SA(1, 0), cA + kstep, voffA); PG8_STAGE(PG8_SB(1, 1), cB + hstep + kstep, voffB);
        PG8_WAIT_V(6); PG8_BAR;
    }
    for (;;) {
        const bool has_next = S.next(ui + 1, nxt);
        const char* nA = has_next ? (const char*)g.A + (size_t)nxt.pm * tstep : cA; const char* nB = has_next ? (const char*)g.Bt + (size_t)nxt.pn * tstep : cB;
        for (int t = 0; t < nt; t += 2) {
            const bool last = (t == nt - 2);
            const char* a1 = cA + (size_t)(t + 1) * kstep;
            const char* a2 = last ? nA : cA + (size_t)(t + 2) * kstep; const char* b2 = last ? nB : cB + (size_t)(t + 2) * kstep;
            const char* a3 = a2 + kstep; const char* b3 = b2 + kstep;
            if (last && has_next) S.a_ready(nxt);
            if constexpr (SP2) {
            PG8_LDB(B0, 0, 0); PG8_LDB(B1, 0, 1); PG8_SCHED; PG8_LDA(At, 0, 0); PG8_STAGE(PG8_SA(1, 1), a1 + hstep, voffA);
            PG8_WAIT_V(8); PG8_WAIT_L(0); PG8_BAR; PG8_MMA(0, 0, At, B0); PG8_MMA(0, 1, At, B1); PG8_BAR; PG8_SCHED;
            PG8_LDA(At, 0, 1); PG8_STAGE(PG8_SB(0, 0), b2, voffB); PG8_STAGE(PG8_SB(0, 1), b2 + hstep, voffB); PG8_STAGE(PG8_SA(0, 0), a2, voffA);
            PG8_WAIT_V(8); PG8_WAIT_L(0); PG8_BAR; PG8_MMA(1, 0, At, B0); PG8_MMA(1, 1, At, B1); PG8_BAR; PG8_SCHED;
            PG8_LDB(B0, 1, 0); PG8_LDB(B1, 1, 1); PG8_SCHED; PG8_LDA(At, 1, 0); PG8_STAGE(PG8_SA(0, 1), a2 + hstep, voffA);
            PG8_WAIT_V(8); PG8_WAIT_L(0); PG8_BAR; PG8_MMA(0, 0, At, B0); PG8_MMA(0, 1, At, B1); PG8_BAR; PG8_SCHED;
            PG8_LDA(At, 1, 1); PG8_STAGE(PG8_SB(1, 0), b3, voffB); PG8_STAGE(PG8_SB(1, 1), b3 + hstep, voffB); PG8_STAGE(PG8_SA(1, 0), a3, voffA);
            PG8_WAIT_V(8); PG8_WAIT_L(0); PG8_BAR; PG8_MMA(1, 0, At, B0); PG8_MMA(1, 1, At, B1); PG8_BAR; PG8_SCHED;
            } else {
            PG8_LDB(B0, 0, 0); PG8_SCHED; PG8_LDA(At, 0, 0); PG8_STAGE(PG8_SA(1, 1), a1 + hstep, voffA);
            PG8_WAIT_L(8); PG8_BAR; PG8_WAIT_L(0); PG8_MMA(0, 0, At, B0); PG8_BAR; PG8_SCHED;
            PG8_LDB(B1, 0, 1); PG8_STAGE(PG8_SB(0, 0), b2, voffB);
            PG8_BAR; PG8_WAIT_L(0); PG8_MMA(0, 1, At, B1); PG8_BAR;
            PG8_LDA(At, 0, 1); PG8_STAGE(PG8_SA(0, 0), a2, voffA);
            PG8_BAR; PG8_WAIT_L(0); PG8_MMA(1, 0, At, B0); PG8_BAR; PG8_SCHED;
            PG8_STAGE(PG8_SB(0, 1), b2 + hstep, voffB);
            PG8_WAIT_V(6); PG8_BAR; PG8_MMA(1, 1, At, B1); PG8_BAR;
            PG8_LDB(B0, 1, 0); PG8_SCHED; PG8_LDA(At, 1, 0); PG8_STAGE(PG8_SA(0, 1), a2 + hstep, voffA);
            PG8_WAIT_L(8); PG8_BAR; PG8_WAIT_L(0); PG8_MMA(0, 0, At, B0); PG8_BAR; PG8_SCHED;
            PG8_LDB(B1, 1, 1); PG8_STAGE(PG8_SB(1, 0), b3, voffB);
            PG8_BAR; PG8_WAIT_L(0); PG8_MMA(0, 1, At, B1); PG8_BAR;
            PG8_LDA(At, 1, 1); PG8_STAGE(PG8_SA(1, 0), a3, voffA);
            PG8_BAR; PG8_WAIT_L(0); PG8_MMA(1, 0, At, B0); PG8_BAR; PG8_SCHED;
            PG8_STAGE(PG8_SB(1, 1), b3 + hstep, voffB);
            PG8_WAIT_V(6); PG8_BAR; PG8_MMA(1, 1, At, B1); PG8_BAR;
            }
        }
        if constexpr (ALIGN_EPI) { if (wr == 0) PG8_BAR; }
        if constexpr (!Epi::AFTER_DRAIN) { E(acc, cur, wr, wc, fr, fq); S.done(cur); }
        if (!has_next) break;
#pragma unroll
        for (int a = 0; a < 2; ++a)
#pragma unroll
            for (int b = 0; b < 2; ++b)
#pragma unroll
                for (int m = 0; m < 4; ++m)
#pragma unroll
                    for (int n = 0; n < 2; ++n) acc[a][b][m][n] = (f32x4){0.f, 0.f, 0.f, 0.f};
        cur = nxt; cA = nA; cB = nB; ++ui;
        if constexpr (ALIGN_EPI) { if (wr == 1) PG8_BAR; }
    }
    PG8_WAIT_V(0);
    if constexpr (!ALIGN_EPI) { if (wr == 0) PG8_BAR; }
    PG8_BAR;
    if constexpr (Epi::AFTER_DRAIN) { E.fused(acc, cur, wr, wc, fr, fq, lds, wid, lane); S.done(cur); }
#undef PG8_SA
#undef PG8_SB
#undef PG8_STAGE
#undef PG8_LDA
#undef PG8_LDB
#undef PG8_MMA
#undef PG8_WAIT_V
#undef PG8_WAIT_L
#undef PG8_BAR
#undef PG8_SCHED
}
}
#define LAS __attribute__((address_space(3)))
typedef pg8::bf16_t bf16_t;
typedef pg8::bf16x8 bf16x8;
typedef pg8::f32x4 f32x4;
typedef pg8::u32x4 u32x4;
typedef float f32x16 __attribute__((ext_vector_type(16)));
typedef short v4i16_t __attribute__((ext_vector_type(4)));
typedef unsigned u32x2 __attribute__((ext_vector_type(2)));

constexpr int BATCH = 8, SEQ = 4096, DM = 1024, DEPTH = 2, T = BATCH * SEQ;
constexpr int FF = 2816, NGU = 2 * FF, NPROJ = 2816, IN_COLS = 2694;
constexpr int FOXH = 6, DIFFH = 4, SGUH = 6;
constexpr float LOG2E = 1.4426950408889634f;
constexpr float LN_EPS = 1e-5f;
constexpr float ALPHA = 1.4142135623730951f;
constexpr int PJ_FQ = 0, PJ_FK = 384, PJ_FV = 768, PJ_DQ = 1152, PJ_DK = 1408, PJ_DV = 1664, PJ_SU = 1920, PJ_SG = 2304;

constexpr size_t MiB = 1u << 20;
constexpr size_t WS_CTL = 0;
constexpr size_t WS_WGU = 2 * MiB;
constexpr size_t WS_WD = 46 * MiB;
constexpr size_t WS_WIN = 68 * MiB;
constexpr size_t WS_WOUT = 79 * MiB;
constexpr size_t WS_WSG = 83 * MiB;
constexpr size_t WS_LF = 84 * MiB;
constexpr size_t WS_C = 85 * MiB;
constexpr size_t WS_HB = 88 * MiB;
constexpr size_t WS_YMIX = 152 * MiB;
constexpr size_t WS_HID = 216 * MiB;
constexpr size_t WS_END = 392 * MiB;
constexpr int LDS_BYTES = 131072 + 256;
constexpr int LDS_SCHED = 131072;

struct Params {
    const float* x; const float* ffn_a_g; const float* ffn_a_u; const float* ffn_a_d; const float* norm_a_g; const float* norm_a_b;
    const float* w_in; const float* f_bias; const float* lq1; const float* lk1; const float* lq2; const float* lk2;
    const float* diff_norm_g; const float* sgu_ng; const float* sgu_nb; const float* sgu_w; const float* sgu_b; const float* w_out;
    const float* norm_m_g; const float* norm_m_b; const float* ffn_b_g; const float* ffn_b_u; const float* ffn_b_d; const float* norm_b_g; const float* norm_b_b;
    float* out; unsigned char* ws;
};

typedef const __attribute__((address_space(4))) Params* PP;
__device__ __forceinline__ PP parg() {
    PP q = (PP)__builtin_amdgcn_kernarg_segment_ptr(); unsigned lo = (unsigned)(uintptr_t)q, hi = (unsigned)((uintptr_t)q >> 32);
    asm volatile("" : "+s"(lo), "+s"(hi));
    lo = __builtin_amdgcn_readfirstlane(lo); hi = __builtin_amdgcn_readfirstlane(hi);
    return (PP)(((uintptr_t)hi << 32) | (uintptr_t)lo);
}
__device__ __forceinline__ unsigned cvtpk(float lo, float hi) { return pg8::cvt_pk_bf16(lo, hi); }
__device__ __forceinline__ float bf2f(unsigned short b) { return __uint_as_float((unsigned)b << 16); }
__device__ __forceinline__ float silu_f(float x) { return x * __builtin_amdgcn_rcpf(1.0f + __builtin_amdgcn_exp2f(-LOG2E * x)); }
__device__ __forceinline__ float gelu_tanh_f(float x) { const float u = 0.7978845608028654f * (x + 0.044715f * x * x * x); return x * __builtin_amdgcn_rcpf(1.0f + __builtin_amdgcn_exp2f(-2.0f * LOG2E * u)); }
__device__ __forceinline__ float wave_sum(float v) {
#pragma unroll
    for (int o = 1; o < 64; o <<= 1) v += __shfl_xor(v, o);
    return v;
}

struct EpiSwiGLU {
    static constexpr bool PERM = true, AFTER_DRAIN = false;
    bf16_t* O;
    __device__ __forceinline__ void operator()(const f32x4 (&acc)[2][2][4][2], const pg8::Unit& u, int wr, int wc, int fr, int fq) const {
        const int row0 = u.pm * 256 + wr * 64 + fr, col0 = u.pn * 128 + wc * 32 + 8 * fq;
#pragma unroll
        for (int ai = 0; ai < 2; ++ai)
#pragma unroll
            for (int m = 0; m < 4; ++m) {
                bf16_t* rowp = O + (size_t)(row0 + ai * 128 + m * 16) * FF + col0;
                const f32x4 g0 = acc[ai][0][m][0], g1 = acc[ai][0][m][1], u0 = acc[ai][1][m][0], u1 = acc[ai][1][m][1];
                float h[8];
#pragma unroll
                for (int j = 0; j < 4; ++j) { h[j] = silu_f(g0[j]) * u0[j]; h[4 + j] = silu_f(g1[j]) * u1[j]; }
                u32x4 w; w.x = cvtpk(h[0], h[1]); w.y = cvtpk(h[2], h[3]); w.z = cvtpk(h[4], h[5]); w.w = cvtpk(h[6], h[7]);
                *(u32x4*)rowp = w;
            }
    }
};
struct EpiProj {
    static constexpr bool PERM = true, AFTER_DRAIN = false;
    bf16_t* O; float* LF; const float* fbias;
    __device__ __forceinline__ void operator()(const f32x4 (&acc)[2][2][4][2], const pg8::Unit& u, int wr, int wc, int fr, int fq) const {
        const int row0 = u.pm * 256 + wr * 64 + fr;
#pragma unroll
        for (int bj = 0; bj < 2; ++bj) {
            const int blk = 2 * u.pn + bj;
            if (blk == 21) {
                if (wc == 0 && fq == 0) {
#pragma unroll
                    for (int ai = 0; ai < 2; ++ai)
#pragma unroll
                        for (int m = 0; m < 4; ++m) {
                            const int row = row0 + ai * 128 + m * 16;
                            const f32x4 v0 = acc[ai][bj][m][0], v1 = acc[ai][bj][m][1];
#pragma unroll
                            for (int j = 0; j < 6; ++j) { const float xx = (j < 4 ? v0[j & 3] : v1[j & 3]) + fbias[j]; LF[(size_t)row * 8 + j] = (fminf(xx, 0.f) - log1pf(__expf(-fabsf(xx)))) * LOG2E; }
                        }
                }
            } else {
                const float sc = (blk < 3) ? 0.125f * LOG2E : ((blk == 9 || blk == 10) ? 0.17677669529663687f * LOG2E : 1.0f);
                const bool gel = (blk >= 15);
                const int col0 = blk * 128 + wc * 32 + 8 * fq;
#pragma unroll
                for (int ai = 0; ai < 2; ++ai)
#pragma unroll
                    for (int m = 0; m < 4; ++m) {
                        bf16_t* rowp = O + (size_t)(row0 + ai * 128 + m * 16) * NPROJ + col0;
                        f32x4 v0 = acc[ai][bj][m][0], v1 = acc[ai][bj][m][1];
                        if (gel) {
#pragma unroll
                            for (int j = 0; j < 4; ++j) { v0[j] = gelu_tanh_f(v0[j]); v1[j] = gelu_tanh_f(v1[j]); }
                        }
                        v0 = v0 * sc; v1 = v1 * sc;
                        u32x4 w; w.x = cvtpk(v0[0], v0[1]); w.y = cvtpk(v0[2], v0[3]); w.z = cvtpk(v1[0], v1[1]); w.w = cvtpk(v1[2], v1[3]);
                        *(u32x4*)rowp = w;
                    }
            }
        }
    }
};
struct EpiResid {
    static constexpr bool PERM = false, AFTER_DRAIN = false;
    const float* base; float* out; float ca, cb;
    __device__ __forceinline__ void operator()(const f32x4 (&acc)[2][2][4][2], const pg8::Unit& u, int wr, int wc, int fr, int fq) const {
        const int row0 = u.pm * 256 + wr * 64 + fr, col0 = u.pn * 256 + wc * 32 + 4 * fq;
#pragma unroll
        for (int ai = 0; ai < 2; ++ai)
#pragma unroll
            for (int m = 0; m < 4; ++m) {
                const size_t off = (size_t)(row0 + ai * 128 + m * 16) * DM + col0;
#pragma unroll
                for (int bj = 0; bj < 2; ++bj)
#pragma unroll
                    for (int n = 0; n < 2; ++n) {
                        const f32x4 bs = *(const f32x4*)(base + off + bj * 128 + n * 16);
                        *(f32x4*)(out + off + bj * 128 + n * 16) = bs * ca + acc[ai][bj][m][n] * cb;
                    }
            }
    }
};

__device__ __forceinline__ void p0_item(const float* W, int ldw, int K, int k0, int src0, int nvalid, bf16_t* WT, int drow0, LAS float* scr, int lane) {
    const int c32 = lane & 31; const bool ok = c32 < nvalid;
#pragma unroll 8
    for (int i = 0; i < 32; ++i) { const int kk = 2 * i + (lane >> 5); scr[kk * 33 + c32] = ok ? W[(size_t)(k0 + kk) * ldw + src0 + c32] : 0.f; }
    asm volatile("s_waitcnt lgkmcnt(0)" ::: "memory");
    const int c = lane & 7;
#pragma unroll
    for (int j = 0; j < 4; ++j) {
        const int n = (lane >> 3) + 8 * j; const LAS float* s = scr + (8 * c) * 33 + n;
        u32x4 o; o.x = cvtpk(s[0 * 33], s[1 * 33]); o.y = cvtpk(s[2 * 33], s[3 * 33]); o.z = cvtpk(s[4 * 33], s[5 * 33]); o.w = cvtpk(s[6 * 33], s[7 * 33]);
        *(u32x4*)(WT + (size_t)(drow0 + n) * K + k0 + 8 * c) = o;
    }
    asm volatile("s_waitcnt lgkmcnt(0)" ::: "memory");
}
__device__ __forceinline__ void prologue(PP p, LAS unsigned char* lds, int G) {
    int tid_ = threadIdx.x; asm volatile("" : "+v"(tid_)); const int tid = tid_, lane = tid & 63, wave = tid >> 6;
    LAS float* scr = (LAS float*)(lds + wave * 16384);
    const int gw = blockIdx.x * 8 + wave, NGW = G * 8;
    unsigned char* ws = p->ws;
    constexpr int I_G = 88 * 16, I_D = 44 * 32, I_IN = 88 * 16, I_OUT = 16 * 32;
    constexpr int PER_L = 6 * I_G + I_IN + I_OUT;
    static_assert(I_G == I_D, "items");
    for (int it = gw; it < DEPTH * PER_L; it += NGW) {
        const int l = it / PER_L; int r = it % PER_L;
        if (r < 6 * I_G) {
            const int w = r / I_G; r %= I_G; const int ab = w / 3, kind = w % 3;
            if (kind < 2) {
                const float* W = (ab == 0 ? (kind == 0 ? p->ffn_a_g : p->ffn_a_u) : (kind == 0 ? p->ffn_b_g : p->ffn_b_u)) + (size_t)l * DM * FF;
                bf16_t* WT = (bf16_t*)(ws + WS_WGU) + (size_t)(l * 2 + ab) * NGU * DM;
                const int kb = r / 88, nb = r % 88, n0 = 32 * nb;
                p0_item(W, FF, DM, 64 * kb, n0, 32, WT, (n0 / 128) * 256 + (n0 % 128) + kind * 128, scr, lane);
            } else {
                const float* W = (ab == 0 ? p->ffn_a_d : p->ffn_b_d) + (size_t)l * FF * DM;
                bf16_t* WT = (bf16_t*)(ws + WS_WD) + (size_t)(l * 2 + ab) * DM * FF;
                const int kb = r / 32, nb = r % 32;
                p0_item(W, DM, FF, 64 * kb, 32 * nb, 32, WT, 32 * nb, scr, lane);
            }
        } else if (r < 6 * I_G + I_IN) {
            r -= 6 * I_G;
            const float* W = p->w_in + (size_t)l * DM * IN_COLS; bf16_t* WT = (bf16_t*)(ws + WS_WIN) + (size_t)l * NPROJ * DM;
            const int kb = r / 88, db = r % 88, d0 = 32 * db;
            int src, nv;
            if (d0 < 1152) { src = d0; nv = 32; } else if (d0 < 2688) { src = d0 + 6; nv = 32; } else if (d0 == 2688) { src = 1152; nv = 6; } else { src = 0; nv = 0; }
            p0_item(W, IN_COLS, DM, 64 * kb, src, nv, WT, d0, scr, lane);
        } else {
            r -= 6 * I_G + I_IN;
            const float* W = p->w_out + (size_t)l * DM * DM; bf16_t* WT = (bf16_t*)(ws + WS_WOUT) + (size_t)l * DM * DM;
            const int kb = r / 32, nb = r % 32;
            p0_item(W, DM, DM, 64 * kb, 32 * nb, 32, WT, 32 * nb, scr, lane);
        }
    }
    {
        const size_t n4 = (size_t)T * DM / 4; bf16_t* hb = (bf16_t*)(ws + WS_HB);
        for (size_t i = (size_t)blockIdx.x * 512 + tid; i < n4; i += (size_t)G * 512) {
            const f32x4 v = ((const f32x4*)p->x)[i]; u32x2 o; o.x = cvtpk(v[0], v[1]); o.y = cvtpk(v[2], v[3]); ((u32x2*)hb)[i] = o;
        }
    }
    {
        bf16_t* wsg = (bf16_t*)(ws + WS_WSG); const int n = DEPTH * 6 * 128 * 128;
        for (int i = blockIdx.x * 512 + tid; i < n; i += G * 512) { const int s = i & 127, t = (i >> 7) & 127; const float v = (s <= t) ? p->sgu_w[i] : 0.f; wsg[i] = (bf16_t)(cvtpk(v, 0.f) & 0xffffu); }
    }
    if (blockIdx.x == 0 && tid < 64) {
        unsigned* ctl = (unsigned*)(ws + WS_CTL);
        if (tid < 16) ctl[tid] = 0u;
        for (int l = 0; l < DEPTH; ++l) {
            float a = (lane < 32) ? p->lq1[l * 32 + lane] * p->lk1[l * 32 + lane] : 0.f, b2 = (lane < 32) ? p->lq2[l * 32 + lane] * p->lk2[l * 32 + lane] : 0.f;
            a = wave_sum(a); b2 = wave_sum(b2);
            const float li = 0.8f - 0.6f * expf(-0.3f * (float)l);
            if (lane == 0) { ((float*)ctl)[32 + 2 * l] = expf(a) - expf(b2) + li; ((float*)ctl)[33 + 2 * l] = 1.0f - li; }
        }
    }
}

__device__ __forceinline__ void ln_phase(float* Y, bf16_t* hb, const float* g, const float* b, int G) {
    int tid_ = threadIdx.x; asm volatile("" : "+v"(tid_)); const int tid = tid_, lane = tid & 63, wave = tid >> 6;
    const int gw = blockIdx.x * 8 + wave, NGW = G * 8;
    f32x4 gg[4], bb[4];
#pragma unroll
    for (int j = 0; j < 4; ++j) { gg[j] = ((const f32x4*)g)[lane + 64 * j]; bb[j] = ((const f32x4*)b)[lane + 64 * j]; }
    for (int m = gw; m < T; m += NGW) {
        f32x4* yr = (f32x4*)(Y + (size_t)m * DM) + lane;
        f32x4 v[4]; float s = 0.f;
#pragma unroll
        for (int j = 0; j < 4; ++j) { v[j] = yr[64 * j]; s += (v[j][0] + v[j][1]) + (v[j][2] + v[j][3]); }
        const float mean = wave_sum(s) * (1.f / DM); float s2 = 0.f;
#pragma unroll
        for (int j = 0; j < 4; ++j) { v[j] = v[j] - mean; s2 += (v[j][0] * v[j][0] + v[j][1] * v[j][1]) + (v[j][2] * v[j][2] + v[j][3] * v[j][3]); }
        const float rstd = 1.f / sqrtf(wave_sum(s2) * (1.f / DM) + LN_EPS);
        u32x2* o8 = (u32x2*)(hb + (size_t)m * DM) + lane;
#pragma unroll
        for (int j = 0; j < 4; ++j) {
            const f32x4 o = v[j] * rstd * gg[j] + bb[j];
            yr[64 * j] = o; u32x2 w; w.x = cvtpk(o[0], o[1]); w.y = cvtpk(o[2], o[3]); o8[64 * j] = w;
        }
    }
}

__device__ __forceinline__ void scan_phase(const float* LF, float* C, LAS unsigned char* lds, int G) {
    int tid_ = threadIdx.x; asm volatile("" : "+v"(tid_)); const int tid = tid_, lane = tid & 63, wave = tid >> 6;
    LAS float* wtot = (LAS float*)lds;
    for (int bh = blockIdx.x; bh < BATCH * FOXH; bh += G) {
        const int b = bh / FOXH, h = bh % FOXH;
        float v[8]; float run = 0.f;
#pragma unroll
        for (int j = 0; j < 8; ++j) { run += LF[((size_t)b * SEQ + tid * 8 + j) * 8 + h]; v[j] = run; }
        float inc = run;
#pragma unroll
        for (int o = 1; o < 64; o <<= 1) { const float t = __shfl_up(inc, o); if (lane >= o) inc += t; }
        if (lane == 63) wtot[wave] = inc;
        __syncthreads();
        float base = inc - run;
        for (int w = 0; w < wave; ++w) base += wtot[w];
        float* c = C + (size_t)bh * SEQ + tid * 8;
        *(f32x4*)c = (f32x4){v[0] + base, v[1] + base, v[2] + base, v[3] + base};
        *(f32x4*)(c + 4) = (f32x4){v[4] + base, v[5] + base, v[6] + base, v[7] + base};
        __syncthreads();
    }
}
constexpr int AK_OFF = 0, AK_BUF = 64 * 144, AV_OFF = 2 * AK_BUF, AV_BUF = 8192, AC_OFF = AV_OFF + 2 * AV_BUF, AC_BUF = 256;
__device__ __forceinline__ v4i16_t tr_read(const LAS unsigned char* p) { return __builtin_amdgcn_ds_read_tr16_b64_v4i16((LAS v4i16_t*)p); }
__device__ __forceinline__ float swap_max(float v) { auto rr = __builtin_amdgcn_permlane32_swap(__float_as_uint(v), __float_as_uint(v), false, false); return fmaxf(__uint_as_float(rr[0]), __uint_as_float(rr[1])); }
__device__ __forceinline__ float swap_sum(float v) { auto rr = __builtin_amdgcn_permlane32_swap(__float_as_uint(v), __float_as_uint(v), false, false); return __uint_as_float(rr[0]) + __uint_as_float(rr[1]); }

__device__ __forceinline__ void softmax_pv(f32x16& p0, f32x16& p1, float& m, float& l, f32x16 (&o)[2], const LAS unsigned char* vb) {
    float mx = fmaxf(p0[0], p1[0]);
#pragma unroll
    for (int r = 1; r < 16; ++r) mx = fmaxf(mx, fmaxf(p0[r], p1[r]));
    mx = swap_max(mx);
    float mn = fmaxf(m, mx); mn = (mn == -INFINITY) ? 0.f : mn;
    const float alpha = __builtin_amdgcn_exp2f(m - mn); m = mn;
    float s = 0.f;
#pragma unroll
    for (int r = 0; r < 16; ++r) { p0[r] = __builtin_amdgcn_exp2f(p0[r] - mn); p1[r] = __builtin_amdgcn_exp2f(p1[r] - mn); s += p0[r] + p1[r]; }
    l = l * alpha + s;
#pragma unroll
    for (int r = 0; r < 16; ++r) { o[0][r] *= alpha; o[1][r] *= alpha; }
    u32x4 pw[4];
    pw[0] = (u32x4){cvtpk(p0[0], p0[1]), cvtpk(p0[2], p0[3]), cvtpk(p0[4], p0[5]), cvtpk(p0[6], p0[7])};
    pw[1] = (u32x4){cvtpk(p0[8], p0[9]), cvtpk(p0[10], p0[11]), cvtpk(p0[12], p0[13]), cvtpk(p0[14], p0[15])};
    pw[2] = (u32x4){cvtpk(p1[0], p1[1]), cvtpk(p1[2], p1[3]), cvtpk(p1[4], p1[5]), cvtpk(p1[6], p1[7])};
    pw[3] = (u32x4){cvtpk(p1[8], p1[9]), cvtpk(p1[10], p1[11]), cvtpk(p1[12], p1[13]), cvtpk(p1[14], p1[15])};
#pragma unroll
    for (int dt = 0; dt < 2; ++dt)
#pragma unroll
        for (int ks = 0; ks < 4; ++ks) {
            const v4i16_t lo = tr_read(vb + dt * 4096 + ks * 1024), hi4 = tr_read(vb + dt * 4096 + ks * 1024 + 512);
            const bf16x8 vf = (bf16x8){lo[0], lo[1], lo[2], lo[3], hi4[0], hi4[1], hi4[2], hi4[3]};
            o[dt] = __builtin_amdgcn_mfma_f32_32x32x16_bf16(vf, __builtin_bit_cast(bf16x8, pw[ks]), o[dt], 0, 0, 0);
        }
}

template <bool DIFF>
__device__ __forceinline__ void attn_unit(LAS unsigned char* lds, const bf16_t* proj, const float* Cs, bf16_t* Ymix, int b, int h, int qb, float lam, float onemli, const float* dng) {
    int tid_ = threadIdx.x; asm volatile("" : "+v"(tid_)); const int tid = tid_, lane = tid & 63, r32 = lane & 31, hi = lane >> 5, wid = __builtin_amdgcn_readfirstlane(tid >> 6);
    const size_t rowbase = (size_t)b * SEQ;
    const int q0w = qb * 256 + wid * 32, qpos = q0w + r32;
    const int qcol = (DIFF ? PJ_DQ : PJ_FQ) + h * 64, kcol = (DIFF ? PJ_DK : PJ_FK) + h * 64, vcol = (DIFF ? PJ_DV : PJ_FV) + h * 64, ocol = (DIFF ? 384 : 0) + h * 64;
    bf16x8 qr[4];
#pragma unroll
    for (int d0 = 0; d0 < 4; ++d0) qr[d0] = *(const bf16x8*)(proj + (rowbase + qpos) * NPROJ + qcol + d0 * 16 + hi * 8);
    const float* Crow = Cs + (size_t)(b * FOXH + h) * SEQ;
    float cq = 0.f, sl2 = 0.f;
    if (!DIFF) cq = Crow[qpos]; else sl2 = exp2f(-2.0f * (float)(h + 1)) * LOG2E;
    float m0 = -INFINITY, l0 = 0.f, m1 = -INFINITY, l1 = 0.f;
    f32x16 oa[2], ob[2];
    oa[0] = f32x16{}; oa[1] = f32x16{}; ob[0] = f32x16{}; ob[1] = f32x16{};
    const int NT = 4 * (qb + 1);
    const int srow = tid >> 3, sch = tid & 7;
    const bf16_t* kg = proj + (rowbase + srow) * NPROJ + kcol + sch * 8;
    const bf16_t* vg = proj + (rowbase + srow) * NPROJ + vcol + sch * 8;
    const int kst = AK_OFF + srow * 144 + sch * 16, vst = AV_OFF + (sch >> 2) * 4096 + srow * 64 + (sch & 3) * 16;
    u32x4 kreg = *(const u32x4*)kg, vreg = *(const u32x4*)vg; float creg = 0.f;
    if (!DIFF) { if (tid < 64) creg = Crow[tid]; }
    *(LAS u32x4*)(lds + kst) = kreg; *(LAS u32x4*)(lds + vst) = vreg;
    if (!DIFF) { if (tid < 64) *(LAS float*)(lds + AC_OFF + tid * 4) = creg; }
    __syncthreads();
    const LAS unsigned char* kb0 = lds + AK_OFF + r32 * 144 + hi * 16;
    const LAS unsigned char* vb0 = lds + AV_OFF + (4 * hi + ((lane & 15) >> 2)) * 64 + ((lane >> 4) & 1) * 32 + (lane & 3) * 8;
    for (int t = 0; t < NT; ++t) {
        const int buf = t & 1, kv0 = t * 64;
        if (t + 1 < NT) {
            kreg = *(const u32x4*)(kg + (size_t)(kv0 + 64) * NPROJ); vreg = *(const u32x4*)(vg + (size_t)(kv0 + 64) * NPROJ);
            if (!DIFF) { if (tid < 64) creg = Crow[kv0 + 64 + tid]; }
        }
        if (kv0 <= q0w + 31) {
            const bool need_mask = (kv0 + 63 > q0w);
            const LAS unsigned char* kb = kb0 + buf * AK_BUF;
            const LAS unsigned char* vb = vb0 + buf * AV_BUF;
            if (!DIFF) {
                f32x16 p0, p1;
                const LAS float* ck = (const LAS float*)(lds + AC_OFF + buf * AC_BUF);
#pragma unroll
                for (int g = 0; g < 4; ++g) {
                    const f32x4 c0 = *(const LAS f32x4*)(ck + 8 * g + 4 * hi), c1 = *(const LAS f32x4*)(ck + 32 + 8 * g + 4 * hi);
#pragma unroll
                    for (int j = 0; j < 4; ++j) { p0[4 * g + j] = cq - c0[j]; p1[4 * g + j] = cq - c1[j]; }
                }
#pragma unroll
                for (int d0 = 0; d0 < 4; ++d0) {
                    const bf16x8 k0 = *(const LAS bf16x8*)(kb + d0 * 32), k1 = *(const LAS bf16x8*)(kb + 32 * 144 + d0 * 32);
                    p0 = __builtin_amdgcn_mfma_f32_32x32x16_bf16(k0, qr[d0], p0, 0, 0, 0);
                    p1 = __builtin_amdgcn_mfma_f32_32x32x16_bf16(k1, qr[d0], p1, 0, 0, 0);
                }
                if (need_mask) {
#pragma unroll
                    for (int r = 0; r < 16; ++r) { const int kv = kv0 + (r & 3) + 8 * (r >> 2) + 4 * hi; if (kv > qpos) p0[r] = -INFINITY; if (kv + 32 > qpos) p1[r] = -INFINITY; }
                }
                softmax_pv(p0, p1, m0, l0, oa, vb);
            } else {
#pragma unroll
                for (int mp = 0; mp < 2; ++mp) {
                    f32x16 p0, p1;
                    const float bq = sl2 * (float)(kv0 + 4 * hi - qpos);
#pragma unroll
                    for (int r = 0; r < 16; ++r) { const float off = (float)((r & 3) + 8 * (r >> 2)); p0[r] = fmaf(sl2, off, bq); p1[r] = fmaf(sl2, off + 32.f, bq); }
#pragma unroll
                    for (int d0 = 0; d0 < 2; ++d0) {
                        const bf16x8 k0 = *(const LAS bf16x8*)(kb + (2 * mp + d0) * 32), k1 = *(const LAS bf16x8*)(kb + 32 * 144 + (2 * mp + d0) * 32);
                        p0 = __builtin_amdgcn_mfma_f32_32x32x16_bf16(k0, qr[2 * mp + d0], p0, 0, 0, 0);
                        p1 = __builtin_amdgcn_mfma_f32_32x32x16_bf16(k1, qr[2 * mp + d0], p1, 0, 0, 0);
                    }
                    if (need_mask) {
#pragma unroll
                        for (int r = 0; r < 16; ++r) { const int kv = kv0 + (r & 3) + 8 * (r >> 2) + 4 * hi; if (kv > qpos) p0[r] = -INFINITY; if (kv + 32 > qpos) p1[r] = -INFINITY; }
                    }
                    if (mp == 0) softmax_pv(p0, p1, m0, l0, oa, vb); else softmax_pv(p0, p1, m1, l1, ob, vb);
                }
            }
        }
        if (t + 1 < NT) {
            const int nb = buf ^ 1;
            *(LAS u32x4*)(lds + kst + nb * AK_BUF) = kreg; *(LAS u32x4*)(lds + vst + nb * AV_BUF) = vreg;
            if (!DIFF) { if (tid < 64) *(LAS float*)(lds + AC_OFF + nb * AC_BUF + tid * 4) = creg; }
        }
        __syncthreads();
    }
    bf16_t* orow = Ymix + (rowbase + qpos) * DM + ocol;
    if (!DIFF) {
        const float inv = 1.0f / swap_sum(l0);
#pragma unroll
        for (int dt = 0; dt < 2; ++dt)
#pragma unroll
            for (int g = 0; g < 4; ++g) {
                u32x2 w; w.x = cvtpk(oa[dt][4 * g] * inv, oa[dt][4 * g + 1] * inv); w.y = cvtpk(oa[dt][4 * g + 2] * inv, oa[dt][4 * g + 3] * inv);
                *(u32x2*)(orow + 32 * dt + 8 * g + 4 * hi) = w;
            }
    } else {
        const float i0 = 1.0f / swap_sum(l0), i1 = lam / swap_sum(l1);
        float ss = 0.f;
#pragma unroll
        for (int dt = 0; dt < 2; ++dt)
#pragma unroll
            for (int r = 0; r < 16; ++r) { const float x = oa[dt][r] * i0 - ob[dt][r] * i1; oa[dt][r] = x; ss += x * x; }
        ss = swap_sum(ss);
        const float rs = (1.0f / sqrtf(ss * (1.0f / 64.0f) + LN_EPS)) * onemli;
#pragma unroll
        for (int dt = 0; dt < 2; ++dt)
#pragma unroll
            for (int g = 0; g < 4; ++g) {
                const f32x4 gg = *(const f32x4*)(dng + h * 64 + 32 * dt + 8 * g + 4 * hi);
                u32x2 w; w.x = cvtpk(oa[dt][4 * g] * rs * gg[0], oa[dt][4 * g + 1] * rs * gg[1]); w.y = cvtpk(oa[dt][4 * g + 2] * rs * gg[2], oa[dt][4 * g + 3] * rs * gg[3]);
                *(u32x2*)(orow + 32 * dt + 8 * g + 4 * hi) = w;
            }
    }
}

__device__ __forceinline__ void sgu_unit(LAS unsigned char* lds, const bf16_t* proj, bf16_t* Ymix, size_t tok0, const bf16_t* wsg, const float* lng, const float* lnb, const float* bs) {
    int tid_ = threadIdx.x; asm volatile("" : "+v"(tid_)); const int tid = tid_, lane = tid & 63, r32 = lane & 31, hi = lane >> 5, wid = __builtin_amdgcn_readfirstlane(tid >> 6);
    {
        const int row = tid >> 2, part = tid & 3;
        const bf16_t* src = proj + (tok0 + row) * NPROJ + PJ_SG + part * 96;
        u32x4 ch[12]; float s = 0.f, s2 = 0.f;
#pragma unroll
        for (int c = 0; c < 12; ++c) {
            ch[c] = *(const u32x4*)(src + c * 8);
#pragma unroll
            for (int j = 0; j < 4; ++j) { const unsigned w = ch[c][j]; const float a = __uint_as_float(w << 16), bq = __uint_as_float(w & 0xffff0000u); s += a + bq; s2 += a * a + bq * bq; }
        }
        s += __shfl_xor(s, 1); s += __shfl_xor(s, 2); s2 += __shfl_xor(s2, 1); s2 += __shfl_xor(s2, 2);
        const float mean = s * (1.0f / 384.0f); const float var = fmaxf(s2 * (1.0f / 384.0f) - mean * mean, 0.f);
        const float rstd = 1.0f / sqrtf(var + LN_EPS);
#pragma unroll
        for (int c = 0; c < 12; ++c) {
            const int col = part * 96 + c * 8;
            const f32x4 g0 = *(const f32x4*)(lng + col), g1 = *(const f32x4*)(lng + col + 4), b0 = *(const f32x4*)(lnb + col), b1 = *(const f32x4*)(lnb + col + 4);
            float v[8];
#pragma unroll
            for (int j = 0; j < 4; ++j) { const unsigned w = ch[c][j]; v[2 * j] = __uint_as_float(w << 16); v[2 * j + 1] = __uint_as_float(w & 0xffff0000u); }
            u32x4 o;
            o.x = cvtpk((v[0] - mean) * rstd * g0[0] + b0[0], (v[1] - mean) * rstd * g0[1] + b0[1]);
            o.y = cvtpk((v[2] - mean) * rstd * g0[2] + b0[2], (v[3] - mean) * rstd * g0[3] + b0[3]);
            o.z = cvtpk((v[4] - mean) * rstd * g1[0] + b1[0], (v[5] - mean) * rstd * g1[1] + b1[1]);
            o.w = cvtpk((v[6] - mean) * rstd * g1[2] + b1[2], (v[7] - mean) * rstd * g1[3] + b1[3]);
            *(LAS u32x4*)(lds + (col >> 5) * 8192 + row * 64 + (col & 31) * 2) = o;
        }
    }
    __syncthreads();
    const int tt = wid & 3, dt = wid >> 2;
    const LAS unsigned char* gb0 = lds + (8 * hi + ((lane & 15) >> 2)) * 64 + ((lane >> 4) & 1) * 32 + (lane & 3) * 8;
    for (int hh = 0; hh < SGUH; ++hh) {
        f32x16 acc = f32x16{};
        const bf16_t* wrow = wsg + ((size_t)hh * 128 + 32 * tt + r32) * 128 + 8 * hi;
        const LAS unsigned char* gb = gb0 + (2 * hh + dt) * 8192;
        for (int ks = 0; ks < 2 * (tt + 1); ++ks) {
            const bf16x8 a = *(const bf16x8*)(wrow + 16 * ks);
            const v4i16_t lo = tr_read(gb + ks * 1024), hi4 = tr_read(gb + ks * 1024 + 256);
            const bf16x8 bfr = (bf16x8){lo[0], lo[1], lo[2], lo[3], hi4[0], hi4[1], hi4[2], hi4[3]};
            acc = __builtin_amdgcn_mfma_f32_32x32x16_bf16(a, bfr, acc, 0, 0, 0);
        }
        const int col = hh * 64 + 32 * dt + r32;
#pragma unroll
        for (int r = 0; r < 16; ++r) {
            const int t = 32 * tt + (r & 3) + 8 * (r >> 2) + 4 * hi;
            const float mixed = acc[r] + bs[hh * 128 + t];
            const float uu = bf2f(proj[(tok0 + t) * NPROJ + PJ_SU + col]);
            Ymix[(tok0 + t) * DM + 640 + col] = (bf16_t)(cvtpk(uu * mixed, 0.f) & 0xffffu);
        }
    }
    __syncthreads();
}

constexpr int N_ATT_UNITS = 16 * 80, N_MIX_UNITS = N_ATT_UNITS + BATCH * (SEQ / 128);
__device__ __forceinline__ void mixer_phase(PP p, LAS unsigned char* lds, int l) {
    unsigned char* ws = p->ws;
    unsigned* ctl = (unsigned*)(ws + WS_CTL);
    const bf16_t* proj = (const bf16_t*)(ws + WS_HID); bf16_t* Ymix = (bf16_t*)(ws + WS_YMIX); const float* Cs = (const float*)(ws + WS_C);
    const float lam = ((const float*)ctl)[32 + 2 * l], onemli = ((const float*)ctl)[33 + 2 * l];
    volatile LAS unsigned* sw = (volatile LAS unsigned*)(lds + LDS_SCHED);
    for (;;) {
        if (threadIdx.x == 0) sw[0] = atomicAdd(ctl + l, 1u);
        __syncthreads();
        const unsigned u = sw[0];
        __syncthreads();
        if (u >= (unsigned)N_MIX_UNITS) break;
        if (u < (unsigned)N_ATT_UNITS) {
            const int qb = 15 - (int)(u / 80u), j = (int)(u % 80u);
            if (j < 32) attn_unit<true>(lds, proj, Cs, Ymix, j >> 2, j & 3, qb, lam, onemli, p->diff_norm_g + l * 256);
            else { const int bh = j - 32; attn_unit<false>(lds, proj, Cs, Ymix, bh / FOXH, bh % FOXH, qb, 0.f, 0.f, nullptr); }
        } else {
            const int c = (int)u - N_ATT_UNITS;
            sgu_unit(lds, proj, Ymix, (size_t)c * 128, (const bf16_t*)(ws + WS_WSG) + (size_t)l * 6 * 128 * 128, p->sgu_ng + l * 384, p->sgu_nb + l * 384, p->sgu_b + l * 768);
        }
    }
}
template <class Epi>
__device__ __forceinline__ void run_gemm(LAS unsigned char* lds, const bf16_t* A, const bf16_t* Bt, int N, int K, const Epi& E, int G) {
    pg8::Gemm g{A, Bt, T, N, K}; pg8::StaticOrder S; S.init(T, N, G, (int)blockIdx.x);
    pg8::gemm_phase<Epi, pg8::StaticOrder, true, true>(lds, g, S, E);
}

__global__ void __launch_bounds__(512, 2) fwd_megakernel(Params p) {
    extern __shared__ __attribute__((aligned(16))) unsigned char lds_raw[];
    LAS unsigned char* lds = (LAS unsigned char*)lds_raw;
    cg::grid_group grid = cg::this_grid();
#define PARG() parg()
#define GSZ() ((int)gridDim.x)
#define WGU(q, l, ab) ((const bf16_t*)((q)->ws + WS_WGU) + (size_t)((l) * 2 + (ab)) * NGU * DM)
#define WDN(q, l, ab) ((const bf16_t*)((q)->ws + WS_WD) + (size_t)((l) * 2 + (ab)) * DM * FF)
    prologue(PARG(), lds, GSZ());
    grid.sync();
#pragma nounroll
    for (int l = 0; l < DEPTH; ++l) {
        { PP q = PARG(); EpiSwiGLU E{(bf16_t*)(q->ws + WS_HID)}; run_gemm(lds, (const bf16_t*)(q->ws + WS_HB), WGU(q, l, 0), NGU, DM, E, GSZ()); }
        grid.sync();
        { PP q = PARG(); EpiResid E{l == 0 ? q->x : q->out, q->out, ALPHA, 0.5f}; run_gemm(lds, (const bf16_t*)(q->ws + WS_HID), WDN(q, l, 0), DM, FF, E, GSZ()); }
        grid.sync();
        { PP q = PARG(); ln_phase(q->out, (bf16_t*)(q->ws + WS_HB), q->norm_a_g + l * DM, q->norm_a_b + l * DM, GSZ()); }
        grid.sync();
        { PP q = PARG(); EpiProj E{(bf16_t*)(q->ws + WS_HID), (float*)(q->ws + WS_LF), q->f_bias + l * FOXH};
          run_gemm(lds, (const bf16_t*)(q->ws + WS_HB), (const bf16_t*)(q->ws + WS_WIN) + (size_t)l * NPROJ * DM, NPROJ, DM, E, GSZ()); }
        grid.sync();
        { PP q = PARG(); scan_phase((const float*)(q->ws + WS_LF), (float*)(q->ws + WS_C), lds, GSZ()); }
        grid.sync();
        mixer_phase(PARG(), lds, l);
        grid.sync();
        { PP q = PARG(); EpiResid E{q->out, q->out, ALPHA, 1.0f}; run_gemm(lds, (const bf16_t*)(q->ws + WS_YMIX), (const bf16_t*)(q->ws + WS_WOUT) + (size_t)l * DM * DM, DM, DM, E, GSZ()); }
        grid.sync();
        { PP q = PARG(); ln_phase(q->out, (bf16_t*)(q->ws + WS_HB), q->norm_m_g + l * DM, q->norm_m_b + l * DM, GSZ()); }
        grid.sync();
        { PP q = PARG(); EpiSwiGLU E{(bf16_t*)(q->ws + WS_HID)}; run_gemm(lds, (const bf16_t*)(q->ws + WS_HB), WGU(q, l, 1), NGU, DM, E, GSZ()); }
        grid.sync();
        { PP q = PARG(); EpiResid E{q->out, q->out, ALPHA, 0.5f}; run_gemm(lds, (const bf16_t*)(q->ws + WS_HID), WDN(q, l, 1), DM, FF, E, GSZ()); }
        grid.sync();
        { PP q = PARG(); ln_phase(q->out, (bf16_t*)(q->ws + WS_HB), q->norm_b_g + l * DM, q->norm_b_b + l * DM, GSZ()); }
        if (l + 1 < DEPTH) grid.sync();
    }
}

extern "C" void kernel_launch(void* const* d_in, const int* in_sizes, int n_in, void* d_out, int out_size, void* d_ws, size_t ws_size, hipStream_t stream) {
    static int grid_blocks = 0;
    if (grid_blocks == 0) {
        if (n_in != 25 || in_sizes[0] != T * DM || out_size != T * DM || ws_size < WS_END) { fprintf(stderr, "kernel_launch: unexpected shapes (n_in %d, in0 %d, out %d, ws %zu)\n", n_in, n_in > 0 ? in_sizes[0] : -1, out_size, ws_size); grid_blocks = -1; return; }
        int dev = 0, cus = 0, per_cu = 0;
        hipGetDevice(&dev);
        hipDeviceGetAttribute(&cus, hipDeviceAttributeMultiprocessorCount, dev);
        if (hipFuncSetAttribute((const void*)fwd_megakernel, hipFuncAttributeMaxDynamicSharedMemorySize, LDS_BYTES) != hipSuccess) { fprintf(stderr, "kernel_launch: hipFuncSetAttribute failed\n"); }
        if (hipOccupancyMaxActiveBlocksPerMultiprocessor(&per_cu, (const void*)fwd_megakernel, 512, LDS_BYTES) != hipSuccess || per_cu < 1) { fprintf(stderr, "kernel_launch: occupancy query gave %d\n", per_cu); per_cu = 1; }
        (void)hipGetLastError();
        grid_blocks = cus * per_cu;
    }
    if (grid_blocks < 0) return;
    Params p{};
    const float** pp = (const float**)&p;
    for (int i = 0; i < 25; ++i) pp[i] = (const float*)d_in[i];
    p.out = (float*)d_out; p.ws = (unsigned char*)d_ws;
    void* args[] = {&p};
    hipError_t e = hipLaunchCooperativeKernel((const void*)fwd_megakernel, dim3(grid_blocks), dim3(512), args, LDS_BYTES, stream);
    if (e != hipSuccess) fprintf(stderr, "cooperative launch failed: %s (grid %d)\n", hipGetErrorString(e), grid_blocks);
}
```

```cpp
#include <hip/hip_runtime.h>
#include <hip/hip_cooperative_groups.h>
#include <cstdio>
#include <cstdint>
namespace cg = cooperative_groups;
namespace pg8 {
#define PG8_LAS __attribute__((address_space(3)))
typedef unsigned short bf16_t;
typedef short bf16x8 __attribute__((ext_vector_type(8)));
typedef float f32x4 __attribute__((ext_vector_type(4)));
typedef unsigned u32x4 __attribute__((ext_vector_type(4)));
constexpr int BM = 256, BK = 64, HALF = 128, HTB = HALF * BK * 2  , STAGE_BYTES = 8 * HTB, NXCD = 8, WGM = 8;

__host__ __device__ __forceinline__ int lds_byte(int r, int c) { const int st = (r >> 4) * 2 + (c >> 5), rr = r & 15, cc = c & 31, ob = rr * 64 + cc * 2; return st * 1024 + (ob ^ (((ob >> 9) & 1) << 5)); }
__host__ __device__ __forceinline__ void stage_rc(int b, int& R, int& C) { const int st = b / 1024, sb = b % 1024, swz = sb ^ (((sb >> 9) & 1) << 5); R = (st >> 1) * 16 + swz / 64; C = (st & 1) * 32 + (swz % 64) / 2; }
__host__ __device__ __forceinline__ int perm32(int rho) { const int n = rho >> 4, i = rho & 15; return 8 * (i >> 2) + 4 * n + (i & 3); }

struct Unit { int pm, pn; };
struct Gemm { const bf16_t* A; const bf16_t* Bt; int M, N, K; };

struct StaticOrder {
    int nM, nN, nwg, G, c;
    __host__ __device__ void init(int M, int N, int G_, int c_) { nM = M / BM; nN = N / BM; nwg = nM * nN; G = G_; c = c_; }
    __host__ __device__ bool next(int i, Unit& u) const {
        const long L = (long)i * G + c; if (L >= nwg) return false;
        int wgid = (int)L; { const int q = nwg / NXCD, r = nwg % NXCD, xcd = wgid % NXCD, off = wgid / NXCD; wgid = (xcd < r ? xcd * (q + 1) : r * (q + 1) + (xcd - r) * q) + off; }
        const int nig = WGM * nN, gid = wgid / nig, fm = gid * WGM, gsz = (nM - fm) < WGM ? (nM - fm) : WGM;
        u.pm = fm + ((wgid % nig) % gsz); u.pn = (wgid % nig) / gsz; return true;
    }
    __device__ __forceinline__ void a_ready(const Unit&) const {}
    __device__ __forceinline__ void done(const Unit&) const {}
};
__device__ __forceinline__ unsigned cvt_pk_bf16(float lo, float hi) { unsigned r; asm volatile("v_cvt_pk_bf16_f32 %0, %1, %2" : "=v"(r) : "v"(lo), "v"(hi)); return r; }
typedef float f32x2 __attribute__((ext_vector_type(2)));
template <class Epi, class Sched, bool ALIGN_EPI = false, bool SP2 = false>
__device__ __forceinline__ void gemm_phase(PG8_LAS unsigned char* lds, const Gemm g, const Sched& S, const Epi& E) {
    int tid_ = threadIdx.x; asm volatile("" : "+v"(tid_));
    const int tid = tid_, wid = __builtin_amdgcn_readfirstlane(tid >> 6), lane = tid & 63, wr = wid >> 2, wc = wid & 3, fr = lane & 15, fq = lane >> 4;
    const int K = g.K, nt = K / BK;
    unsigned voffA[2], voffB[2];
#pragma unroll
    for (int i = 0; i < 2; ++i) { int R, C; stage_rc(tid * 16 + i * 8192, R, C); const int Rb = Epi::PERM ? ((R & ~31) + perm32(R & 31)) : R;
        voffA[i] = (unsigned)(R * K + C) * 2u; voffB[i] = (unsigned)(Rb * K + C) * 2u; }
    const size_t kstep = (size_t)(BK * 2);
    const size_t hstep = (size_t)HALF * K * 2;
    const size_t tstep = 2 * hstep;
    const unsigned ldsw = (unsigned)wid * 1024u;
    const int aoff = lds_byte(wr * 64 + fr, fq * 8), boff = lds_byte(wc * 32 + fr, fq * 8);
#define PG8_SA(b, h) (((b) * 2 + (h)) * HTB)
#define PG8_SB(b, h) ((4 + (b) * 2 + (h)) * HTB)
#define PG8_STAGE(bufoff, gbase, voff) do { _Pragma("unroll") for (int _i = 0; _i < 2; ++_i) \
        __builtin_amdgcn_global_load_lds((const unsigned*)((const char*)(gbase) + (voff)[_i]), (PG8_LAS unsigned*)(lds + (bufoff) + ldsw + _i * 8192), 16, 0, 0); } while (0)
#define PG8_LDA(dst, b, h) do { _Pragma("unroll") for (int m = 0; m < 4; ++m) _Pragma("unroll") for (int k = 0; k < 2; ++k) dst[m][k] = *(const PG8_LAS bf16x8*)(lds + PG8_SA(b, h) + aoff + m * 2048 + k * 1024); } while (0)
#define PG8_LDB(dst, b, h) do { _Pragma("unroll") for (int n = 0; n < 2; ++n) _Pragma("unroll") for (int k = 0; k < 2; ++k) dst[n][k] = *(const PG8_LAS bf16x8*)(lds + PG8_SB(b, h) + boff + n * 2048 + k * 1024); } while (0)
#define PG8_MMA(ai, bj, At, Bt) do { __builtin_amdgcn_s_setprio(1); _Pragma("unroll") for (int m = 0; m < 4; ++m) _Pragma("unroll") for (int n = 0; n < 2; ++n) _Pragma("unroll") for (int k = 0; k < 2; ++k) \
        acc[ai][bj][m][n] = __builtin_amdgcn_mfma_f32_16x16x32_bf16(Bt[n][k], At[m][k], acc[ai][bj][m][n], 0, 0, 0); __builtin_amdgcn_s_setprio(0); } while (0)
#define PG8_WAIT_V(n) asm volatile("s_waitcnt vmcnt(" #n ")" ::: "memory")
#define PG8_WAIT_L(n) asm volatile("s_waitcnt lgkmcnt(" #n ")" ::: "memory")
#define PG8_BAR __builtin_amdgcn_s_barrier()
#define PG8_SCHED __builtin_amdgcn_sched_barrier(0)
    Unit cur, nxt; int ui = 0;
    if (!S.next(0, cur)) return;
    f32x4 acc[2][2][4][2];
#pragma unroll
    for (int a = 0; a < 2; ++a)
#pragma unroll
        for (int b = 0; b < 2; ++b)
#pragma unroll
            for (int m = 0; m < 4; ++m)
#pragma unroll
                for (int n = 0; n < 2; ++n) acc[a][b][m][n] = (f32x4){0.f, 0.f, 0.f, 0.f};
    bf16x8 At[4][2], B0[2][2], B1[2][2];
    const char* cA = (const char*)g.A + (size_t)cur.pm * tstep; const char* cB = (const char*)g.Bt + (size_t)cur.pn * tstep;
    S.a_ready(cur);
    if constexpr (SP2) {
        PG8_STAGE(PG8_SB(0, 0), cB, voffB); PG8_STAGE(PG8_SB(0, 1), cB + hstep, voffB); PG8_STAGE(PG8_SA(0, 0), cA, voffA); PG8_STAGE(PG8_SA(0, 1), cA + hstep, voffA);
        if (wr == 1) PG8_BAR;
        PG8_WAIT_V(2); PG8_BAR;
        PG8_STAGE(PG8_SB(1, 0), cB + kstep, voffB); PG8_STAGE(PG8_SA(1, 0), cA + kstep, voffA); PG8_STAGE(PG8_SB(1, 1), cB + hstep + kstep, voffB);
        PG8_WAIT_V(6); PG8_BAR;
    } else {
        PG8_STAGE(PG8_SB(0, 0), cB, voffB); PG8_STAGE(PG8_SA(0, 0), cA, voffA); PG8_STAGE(PG8_SB(0, 1), cB + hstep, voffB); PG8_STAGE(PG8_SA(0, 1), cA + hstep, voffA);
        if (wr == 1) PG8_BAR;
        PG8_WAIT_V(4); PG8_BAR;
        PG8_STAGE(PG8_SB(1, 0), cB + kstep, voffB); PG8_STAGE(PG8_SA(1, 0), cA + kstep, voffA); PG8_STAGE(PG8_SB(1, 1), cB + hstep + kstep, voffB);
        PG8_WAIT_V(6); PG8_BAR;
    }
    for (;;) {
        const bool has_next = S.next(ui + 1, nxt);
        const char* nA = has_next ? (const char*)g.A + (size_t)nxt.pm * tstep : cA; const char* nB = has_next ? (const char*)g.Bt + (size_t)nxt.pn * tstep : cB;
        for (int t = 0; t < nt; t += 2) {
            const bool last = (t == nt - 2);
            const char* a1 = cA + (size_t)(t + 1) * kstep;
            const char* a2 = last ? nA : cA + (size_t)(t + 2) * kstep; const char* b2 = last ? nB : cB + (size_t)(t + 2) * kstep;
            const char* a3 = a2 + kstep; const char* b3 = b2 + kstep;
            if (last && has_next) S.a_ready(nxt);
            if constexpr (SP2) {
            PG8_LDB(B0, 0, 0); PG8_LDB(B1, 0, 1); PG8_SCHED; PG8_LDA(At, 0, 0); PG8_STAGE(PG8_SA(1, 1), a1 + hstep, voffA);
            PG8_WAIT_V(8); PG8_WAIT_L(0); PG8_BAR; PG8_MMA(0, 0, At, B0); PG8_MMA(0, 1, At, B1); PG8_BAR; PG8_SCHED;
            PG8_LDA(At, 0, 1); PG8_STAGE(PG8_SB(0, 0), b2, voffB); PG8_STAGE(PG8_SB(0, 1), b2 + hstep, voffB); PG8_STAGE(PG8_SA(0, 0), a2, voffA);
            PG8_WAIT_V(8); PG8_WAIT_L(0); PG8_BAR; PG8_MMA(1, 0, At, B0); PG8_MMA(1, 1, At, B1); PG8_BAR; PG8_SCHED;
            PG8_LDB(B0, 1, 0); PG8_LDB(B1, 1, 1); PG8_SCHED; PG8_LDA(At, 1, 0); PG8_STAGE(PG8_SA(0, 1), a2 + hstep, voffA);
            PG8_WAIT_V(8); PG8_WAIT_L(0); PG8_BAR; PG8_MMA(0, 0, At, B0); PG8_MMA(0, 1, At, B1); PG8_BAR; PG8_SCHED;
            PG8_LDA(At, 1, 1); PG8_STAGE(PG8_SB(1, 0), b3, voffB); PG8_STAGE(PG8_SB(1, 1), b3 + hstep, voffB); PG8_STAGE(PG8_SA(1, 0), a3, voffA);
            PG8_WAIT_V(8); PG8_WAIT_L(0); PG8_BAR; PG8_MMA(1, 0, At, B0); PG8_MMA(1, 1, At, B1); PG8_BAR; PG8_SCHED;
            } else {
            PG8_LDB(B0, 0, 0); PG8_SCHED; PG8_LDA(At, 0, 0); PG8_STAGE(PG8_SA(1, 1), a1 + hstep, voffA);
            PG8_WAIT_L(8); PG8_BAR; PG8_WAIT_L(0); PG8_MMA(0, 0, At, B0); PG8_BAR; PG8_SCHED;
            PG8_LDB(B1, 0, 1); PG8_STAGE(PG8_SB(0, 0), b2, voffB);
            PG8_BAR; PG8_WAIT_L(0); PG8_MMA(0, 1, At, B1); PG8_BAR;
            PG8_LDA(At, 0, 1); PG8_STAGE(PG8_SA(0, 0), a2, voffA);
            PG8_BAR; PG8_WAIT_L(0); PG8_MMA(1, 0, At, B0); PG8_BAR; PG8_SCHED;
            PG8_STAGE(PG8_SB(0, 1), b2 + hstep, voffB);
            PG8_WAIT_V(6); PG8_BAR; PG8_MMA(1, 1, At, B1); PG8_BAR;
            PG8_LDB(B0, 1, 0); PG8_SCHED; PG8_LDA(At, 1, 0); PG8_STAGE(PG8_SA(0, 1), a2 + hstep, voffA);
            PG8_WAIT_L(8); PG8_BAR; PG8_WAIT_L(0); PG8_MMA(0, 0, At, B0); PG8_BAR; PG8_SCHED;
            PG8_LDB(B1, 1, 1); PG8_STAGE(PG8_SB(1, 0), b3, voffB);
            PG8_BAR; PG8_WAIT_L(0); PG8_MMA(0, 1, At, B1); PG8_BAR;
            PG8_LDA(At, 1, 1); PG8_STAGE(PG8_SA(1, 0), a3, voffA);
            PG8_BAR; PG8_WAIT_L(0); PG8_MMA(1, 0, At, B0); PG8_BAR; PG8_SCHED;
            PG8_STAGE(PG8_SB(1, 1), b3 + hstep, voffB);
            PG8_WAIT_V(6); PG8_BAR; PG8_MMA(1, 1, At, B1); PG8_BAR;
            }
        }
        if constexpr (ALIGN_EPI) { if (wr == 0) PG8_BAR; }
        if constexpr (!Epi::AFTER_DRAIN) { E(acc, cur, wr, wc, fr, fq); S.done(cur); }
        if (!has_next) break;
#pragma unroll
        for (int a = 0; a < 2; ++a)
#pragma unroll
            for (int b = 0; b < 2; ++b)
#pragma unroll
                for (int m = 0; m < 4; ++m)
#pragma unroll
                    for (int n = 0; n < 2; ++n) acc[a][b][m][n] = (f32x4){0.f, 0.f, 0.f, 0.f};
        cur = nxt; cA = nA; cB = nB; ++ui;
        if constexpr (ALIGN_EPI) { if (wr == 1) PG8_BAR; }
    }
    PG8_WAIT_V(0);
    if constexpr (!ALIGN_EPI) { if (wr == 0) PG8_BAR; }
    PG8_BAR;
    if constexpr (Epi::AFTER_DRAIN) { E.fused(acc, cur, wr, wc, fr, fq, lds, wid, lane); S.done(cur); }
#undef PG8_SA
#undef PG8_SB
#undef PG8_STAGE
#undef PG8_LDA
#undef PG8_LDB
#undef PG8_MMA
#undef PG8_WAIT_V
#undef PG8_WAIT_L
#undef PG8_BAR
#undef PG8_SCHED
}
}
#define LAS __attribute__((address_space(3)))
typedef pg8::bf16_t bf16_t;
typedef pg8::bf16x8 bf16x8;
typedef pg8::f32x4 f32x4;
typedef pg8::u32x4 u32x4;
typedef float f32x16 __attribute__((ext_vector_type(16)));
typedef short v4i16_t __attribute__((ext_vector_type(4)));
typedef unsigned u32x2 __attribute__((ext_vector_type(2)));

constexpr int BATCH = 8, SEQ = 4096, DM = 1024, DEPTH = 2, T = BATCH * SEQ;
constexpr int FF = 2816, NGU = 2 * FF, NPROJ = 2816, IN_COLS = 2694;
constexpr int FOXH = 6, DIFFH = 4, SGUH = 6;
constexpr float LOG2E = 1.4426950408889634f;
constexpr float LN_EPS = 1e-5f;
constexpr float ALPHA = 1.4142135623730951f;
constexpr int PJ_FQ = 0, PJ_FK = 384, PJ_FV = 768, PJ_DQ = 1152, PJ_DK = 1408, PJ_DV = 1664, PJ_SU = 1920, PJ_SG = 2304;

constexpr size_t MiB = 1u << 20;
constexpr size_t WS_CTL = 0;
constexpr size_t WS_WGU = 2 * MiB;
constexpr size_t WS_WD = 46 * MiB;
constexpr size_t WS_WIN = 68 * MiB;
constexpr size_t WS_WOUT = 79 * MiB;
constexpr size_t WS_WSG = 83 * MiB;
constexpr size_t WS_LF = 84 * MiB;
constexpr size_t WS_C = 85 * MiB;
constexpr size_t WS_HB = 88 * MiB;
constexpr size_t WS_YMIX = 152 * MiB;
constexpr size_t WS_HID = 216 * MiB;
constexpr size_t WS_END = 392 * MiB;
constexpr int LDS_BYTES = 131072 + 256;
constexpr int LDS_SCHED = 131072;

struct Params {
    const float* x; const float* ffn_a_g; const float* ffn_a_u; const float* ffn_a_d; const float* norm_a_g; const float* norm_a_b;
    const float* w_in; const float* f_bias; const float* lq1; const float* lk1; const float* lq2; const float* lk2;
    const float* diff_norm_g; const float* sgu_ng; const float* sgu_nb; const float* sgu_w; const float* sgu_b; const float* w_out;
    const float* norm_m_g; const float* norm_m_b; const float* ffn_b_g; const float* ffn_b_u; const float* ffn_b_d; const float* norm_b_g; const float* norm_b_b;
    float* out; unsigned char* ws;
};

typedef const __attribute__((address_space(4))) Params* PP;
__device__ __forceinline__ PP parg() {
    PP q = (PP)__builtin_amdgcn_kernarg_segment_ptr(); unsigned lo = (unsigned)(uintptr_t)q, hi = (unsigned)((uintptr_t)q >> 32);
    asm volatile("" : "+s"(lo), "+s"(hi));
    lo = __builtin_amdgcn_readfirstlane(lo); hi = __builtin_amdgcn_readfirstlane(hi);
    return (PP)(((uintptr_t)hi << 32) | (uintptr_t)lo);
}
__device__ __forceinline__ unsigned cvtpk(float lo, float hi) { return pg8::cvt_pk_bf16(lo, hi); }
__device__ __forceinline__ float bf2f(unsigned short b) { return __uint_as_float((unsigned)b << 16); }
__device__ __forceinline__ float silu_f(float x) { return x * __builtin_amdgcn_rcpf(1.0f + __builtin_amdgcn_exp2f(-LOG2E * x)); }
__device__ __forceinline__ float gelu_tanh_f(float x) { const float u = 0.7978845608028654f * (x + 0.044715f * x * x * x); return x * __builtin_amdgcn_rcpf(1.0f + __builtin_amdgcn_exp2f(-2.0f * LOG2E * u)); }
__device__ __forceinline__ float wave_sum(float v) {
#pragma unroll
    for (int o = 1; o < 64; o <<= 1) v += __shfl_xor(v, o);
    return v;
}

struct EpiSwiGLU {
    static constexpr bool PERM = true, AFTER_DRAIN = false;
    bf16_t* O;
    __device__ __forceinline__ void operator()(const f32x4 (&acc)[2][2][4][2], const pg8::Unit& u, int wr, int wc, int fr, int fq) const {
        const int row0 = u.pm * 256 + wr * 64 + fr, col0 = u.pn * 128 + wc * 32 + 8 * fq;
#pragma unroll
        for (int ai = 0; ai < 2; ++ai)
#pragma unroll
            for (int m = 0; m < 4; ++m) {
                bf16_t* rowp = O + (size_t)(row0 + ai * 128 + m * 16) * FF + col0;
                const f32x4 g0 = acc[ai][0][m][0], g1 = acc[ai][0][m][1], u0 = acc[ai][1][m][0], u1 = acc[ai][1][m][1];
                float h[8];
#pragma unroll
                for (int j = 0; j < 4; ++j) { h[j] = silu_f(g0[j]) * u0[j]; h[4 + j] = silu_f(g1[j]) * u1[j]; }
                u32x4 w; w.x = cvtpk(h[0], h[1]); w.y = cvtpk(h[2], h[3]); w.z = cvtpk(h[4], h[5]); w.w = cvtpk(h[6], h[7]);
                *(u32x4*)rowp = w;
            }
    }
};
struct EpiProj {
    static constexpr bool PERM = true, AFTER_DRAIN = false;
    bf16_t* O; float* LF; const float* fbias;
    __device__ __forceinline__ void operator()(const f32x4 (&acc)[2][2][4][2], const pg8::Unit& u, int wr, int wc, int fr, int fq) const {
        const int row0 = u.pm * 256 + wr * 64 + fr;
#pragma unroll
        for (int bj = 0; bj < 2; ++bj) {
            const int blk = 2 * u.pn + bj;
            if (blk == 21) {
                if (wc == 0 && fq == 0) {
#pragma unroll
                    for (int ai = 0; ai < 2; ++ai)
#pragma unroll
                        for (int m = 0; m < 4; ++m) {
                            const int row = row0 + ai * 128 + m * 16;
                            const f32x4 v0 = acc[ai][bj][m][0], v1 = acc[ai][bj][m][1];
#pragma unroll
                            for (int j = 0; j < 6; ++j) { const float xx = (j < 4 ? v0[j & 3] : v1[j & 3]) + fbias[j]; LF[(size_t)row * 8 + j] = (fminf(xx, 0.f) - log1pf(__expf(-fabsf(xx)))) * LOG2E; }
                        }
                }
            } else {
                const float sc = (blk < 3) ? 0.125f * LOG2E : ((blk == 9 || blk == 10) ? 0.17677669529663687f * LOG2E : 1.0f);
                const bool gel = (blk >= 15);
                const int col0 = blk * 128 + wc * 32 + 8 * fq;
#pragma unroll
                for (int ai = 0; ai < 2; ++ai)
#pragma unroll
                    for (int m = 0; m < 4; ++m) {
                        bf16_t* rowp = O + (size_t)(row0 + ai * 128 + m * 16) * NPROJ + col0;
                        f32x4 v0 = acc[ai][bj][m][0], v1 = acc[ai][bj][m][1];
                        if (gel) {
#pragma unroll
                            for (int j = 0; j < 4; ++j) { v0[j] = gelu_tanh_f(v0[j]); v1[j] = gelu_tanh_f(v1[j]); }
                        }
                        v0 = v0 * sc; v1 = v1 * sc;
                        u32x4 w; w.x = cvtpk(v0[0], v0[1]); w.y = cvtpk(v0[2], v0[3]); w.z = cvtpk(v1[0], v1[1]); w.w = cvtpk(v1[2], v1[3]);
                        *(u32x4*)rowp = w;
                    }
            }
        }
    }
};
struct EpiResid {
    static constexpr bool PERM = false, AFTER_DRAIN = false;
    const float* base; float* out; float ca, cb;
    __device__ __forceinline__ void operator()(const f32x4 (&acc)[2][2][4][2], const pg8::Unit& u, int wr, int wc, int fr, int fq) const {
        const int row0 = u.pm * 256 + wr * 64 + fr, col0 = u.pn * 256 + wc * 32 + 4 * fq;
#pragma unroll
        for (int ai = 0; ai < 2; ++ai)
#pragma unroll
            for (int m = 0; m < 4; ++m) {
                const size_t off = (size_t)(row0 + ai * 128 + m * 16) * DM + col0;
#pragma unroll
                for (int bj = 0; bj < 2; ++bj)
#pragma unroll
                    for (int n = 0; n < 2; ++n) {
                        const f32x4 bs = *(const f32x4*)(base + off + bj * 128 + n * 16);
                        *(f32x4*)(out + off + bj * 128 + n * 16) = bs * ca + acc[ai][bj][m][n] * cb;
                    }
            }
    }
};

__device__ __forceinline__ void p0_item(const float* W, int ldw, int K, int k0, int src0, int nvalid, bf16_t* WT, int drow0, LAS float* scr, int lane) {
    const int c32 = lane & 31; const bool ok = c32 < nvalid;
    float wv[32];
#pragma unroll
    for (int i = 0; i < 32; ++i) { const int kk = 2 * i + (lane >> 5); wv[i] = ok ? W[(size_t)(k0 + kk) * ldw + src0 + c32] : 0.f; }
#pragma unroll
    for (int i = 0; i < 32; ++i) { const int kk = 2 * i + (lane >> 5); scr[kk * 33 + c32] = wv[i]; }
    asm volatile("s_waitcnt lgkmcnt(0)" ::: "memory");
    const int c = lane & 7;
#pragma unroll
    for (int j = 0; j < 4; ++j) {
        const int n = (lane >> 3) + 8 * j; const LAS float* s = scr + (8 * c) * 33 + n;
        u32x4 o; o.x = cvtpk(s[0 * 33], s[1 * 33]); o.y = cvtpk(s[2 * 33], s[3 * 33]); o.z = cvtpk(s[4 * 33], s[5 * 33]); o.w = cvtpk(s[6 * 33], s[7 * 33]);
        *(u32x4*)(WT + (size_t)(drow0 + n) * K + k0 + 8 * c) = o;
    }
    asm volatile("s_waitcnt lgkmcnt(0)" ::: "memory");
}
__device__ __forceinline__ void prologue(PP p, LAS unsigned char* lds, int G) {
    int tid_ = threadIdx.x; asm volatile("" : "+v"(tid_)); const int tid = tid_, lane = tid & 63, wave = tid >> 6;
    LAS float* scr = (LAS float*)(lds + wave * 16384);
    const int gw = blockIdx.x * 8 + wave, NGW = G * 8;
    unsigned char* ws = p->ws;
    constexpr int I_G = 88 * 16, I_D = 44 * 32, I_IN = 88 * 16, I_OUT = 16 * 32;
    constexpr int PER_L = 6 * I_G + I_IN + I_OUT;
    static_assert(I_G == I_D, "items");
    for (int it = gw; it < DEPTH * PER_L; it += NGW) {
        const int l = it / PER_L; int r = it % PER_L;
        if (r < 6 * I_G) {
            const int w = r / I_G; r %= I_G; const int ab = w / 3, kind = w % 3;
            if (kind < 2) {
                const float* W = (ab == 0 ? (kind == 0 ? p->ffn_a_g : p->ffn_a_u) : (kind == 0 ? p->ffn_b_g : p->ffn_b_u)) + (size_t)l * DM * FF;
                bf16_t* WT = (bf16_t*)(ws + WS_WGU) + (size_t)(l * 2 + ab) * NGU * DM;
                const int kb = r / 88, nb = r % 88, n0 = 32 * nb;
                p0_item(W, FF, DM, 64 * kb, n0, 32, WT, (n0 / 128) * 256 + (n0 % 128) + kind * 128, scr, lane);
            } else {
                const float* W = (ab == 0 ? p->ffn_a_d : p->ffn_b_d) + (size_t)l * FF * DM;
                bf16_t* WT = (bf16_t*)(ws + WS_WD) + (size_t)(l * 2 + ab) * DM * FF;
                const int kb = r / 32, nb = r % 32;
                p0_item(W, DM, FF, 64 * kb, 32 * nb, 32, WT, 32 * nb, scr, lane);
            }
        } else if (r < 6 * I_G + I_IN) {
            r -= 6 * I_G;
            const float* W = p->w_in + (size_t)l * DM * IN_COLS; bf16_t* WT = (bf16_t*)(ws + WS_WIN) + (size_t)l * NPROJ * DM;
            const int kb = r / 88, db = r % 88, d0 = 32 * db;
            int src, nv;
            if (d0 < 1152) { src = d0; nv = 32; } else if (d0 < 2688) { src = d0 + 6; nv = 32; } else if (d0 == 2688) { src = 1152; nv = 6; } else { src = 0; nv = 0; }
            p0_item(W, IN_COLS, DM, 64 * kb, src, nv, WT, d0, scr, lane);
        } else {
            r -= 6 * I_G + I_IN;
            const float* W = p->w_out + (size_t)l * DM * DM; bf16_t* WT = (bf16_t*)(ws + WS_WOUT) + (size_t)l * DM * DM;
            const int kb = r / 32, nb = r % 32;
            p0_item(W, DM, DM, 64 * kb, 32 * nb, 32, WT, 32 * nb, scr, lane);
        }
    }
    {
        const size_t n4 = (size_t)T * DM / 4; bf16_t* hb = (bf16_t*)(ws + WS_HB);
        const size_t stride = (size_t)G * 512;
        for (size_t i = (size_t)blockIdx.x * 512 + tid; i < n4; i += 4 * stride) {
            f32x4 v[4];
#pragma unroll
            for (int j = 0; j < 4; ++j) v[j] = (i + j * stride < n4) ? ((const f32x4*)p->x)[i + j * stride] : (f32x4){0.f, 0.f, 0.f, 0.f};
#pragma unroll
            for (int j = 0; j < 4; ++j) if (i + j * stride < n4) { u32x2 o; o.x = cvtpk(v[j][0], v[j][1]); o.y = cvtpk(v[j][2], v[j][3]); ((u32x2*)hb)[i + j * stride] = o; }
        }
    }
    {
        bf16_t* wsg = (bf16_t*)(ws + WS_WSG); const int n = DEPTH * 6 * 128 * 128;
        for (int i = blockIdx.x * 512 + tid; i < n; i += G * 512) { const int s = i & 127, t = (i >> 7) & 127; const float v = (s <= t) ? p->sgu_w[i] : 0.f; wsg[i] = (bf16_t)(cvtpk(v, 0.f) & 0xffffu); }
    }
    if (blockIdx.x == 0 && tid < 64) {
        unsigned* ctl = (unsigned*)(ws + WS_CTL);
        if (tid < 16) ctl[tid] = 0u;
        for (int l = 0; l < DEPTH; ++l) {
            float a = (lane < 32) ? p->lq1[l * 32 + lane] * p->lk1[l * 32 + lane] : 0.f, b2 = (lane < 32) ? p->lq2[l * 32 + lane] * p->lk2[l * 32 + lane] : 0.f;
            a = wave_sum(a); b2 = wave_sum(b2);
            const float li = 0.8f - 0.6f * expf(-0.3f * (float)l);
            if (lane == 0) { ((float*)ctl)[32 + 2 * l] = expf(a) - expf(b2) + li; ((float*)ctl)[33 + 2 * l] = 1.0f - li; }
        }
    }
}

__device__ __forceinline__ void ln_phase(float* Y, bf16_t* hb, const float* g, const float* b, int G) {
    int tid_ = threadIdx.x; asm volatile("" : "+v"(tid_)); const int tid = tid_, lane = tid & 63, wave = tid >> 6;
    const int gw = blockIdx.x * 8 + wave, NGW = G * 8;
    f32x4 gg[4], bb[4];
#pragma unroll
    for (int j = 0; j < 4; ++j) { gg[j] = ((const f32x4*)g)[lane + 64 * j]; bb[j] = ((const f32x4*)b)[lane + 64 * j]; }
    for (int m0 = gw * 4; m0 < T; m0 += NGW * 4) {
        f32x4 v[4][4];
#pragma unroll
        for (int rr = 0; rr < 4; ++rr) { const f32x4* yr = (const f32x4*)(Y + (size_t)(m0 + rr) * DM) + lane;
#pragma unroll
            for (int j = 0; j < 4; ++j) v[rr][j] = yr[64 * j]; }
#pragma unroll
        for (int rr = 0; rr < 4; ++rr) {
            float s = 0.f;
#pragma unroll
            for (int j = 0; j < 4; ++j) s += (v[rr][j][0] + v[rr][j][1]) + (v[rr][j][2] + v[rr][j][3]);
            const float mean = wave_sum(s) * (1.f / DM); float s2 = 0.f;
#pragma unroll
            for (int j = 0; j < 4; ++j) { v[rr][j] = v[rr][j] - mean; s2 += (v[rr][j][0] * v[rr][j][0] + v[rr][j][1] * v[rr][j][1]) + (v[rr][j][2] * v[rr][j][2] + v[rr][j][3] * v[rr][j][3]); }
            const float rstd = 1.f / sqrtf(wave_sum(s2) * (1.f / DM) + LN_EPS);
            f32x4* yr = (f32x4*)(Y + (size_t)(m0 + rr) * DM) + lane;
            u32x2* o8 = (u32x2*)(hb + (size_t)(m0 + rr) * DM) + lane;
#pragma unroll
            for (int j = 0; j < 4; ++j) {
                const f32x4 o = v[rr][j] * rstd * gg[j] + bb[j];
                yr[64 * j] = o; u32x2 w; w.x = cvtpk(o[0], o[1]); w.y = cvtpk(o[2], o[3]); o8[64 * j] = w;
            }
        }
    }
}

__device__ __forceinline__ void scan_phase(const float* LF, float* C, LAS unsigned char* lds, int G) {
    int tid_ = threadIdx.x; asm volatile("" : "+v"(tid_)); const int tid = tid_, lane = tid & 63, wave = tid >> 6;
    LAS float* wtot = (LAS float*)lds;
    for (int bh = blockIdx.x; bh < BATCH * FOXH; bh += G) {
        const int b = bh / FOXH, h = bh % FOXH;
        float v[8]; float run = 0.f;
#pragma unroll
        for (int j = 0; j < 8; ++j) { run += LF[((size_t)b * SEQ + tid * 8 + j) * 8 + h]; v[j] = run; }
        float inc = run;
#pragma unroll
        for (int o = 1; o < 64; o <<= 1) { const float t = __shfl_up(inc, o); if (lane >= o) inc += t; }
        if (lane == 63) wtot[wave] = inc;
        __syncthreads();
        float base = inc - run;
        for (int w = 0; w < wave; ++w) base += wtot[w];
        float* c = C + (size_t)bh * SEQ + tid * 8;
        *(f32x4*)c = (f32x4){v[0] + base, v[1] + base, v[2] + base, v[3] + base};
        *(f32x4*)(c + 4) = (f32x4){v[4] + base, v[5] + base, v[6] + base, v[7] + base};
        __syncthreads();
    }
}
constexpr int ANS = 4, AK_OFF = 0, AK_BUF = 8192, AV_OFF = ANS * AK_BUF, AV_BUF = 8192, AC_OFF = AV_OFF + ANS * AV_BUF, AC_BUF = 256;
__device__ __forceinline__ v4i16_t tr_read(const LAS unsigned char* p) { return __builtin_amdgcn_ds_read_tr16_b64_v4i16((LAS v4i16_t*)p); }
__device__ __forceinline__ float swap_max(float v) { auto rr = __builtin_amdgcn_permlane32_swap(__float_as_uint(v), __float_as_uint(v), false, false); return fmaxf(__uint_as_float(rr[0]), __uint_as_float(rr[1])); }
__device__ __forceinline__ float swap_sum(float v) { auto rr = __builtin_amdgcn_permlane32_swap(__float_as_uint(v), __float_as_uint(v), false, false); return __uint_as_float(rr[0]) + __uint_as_float(rr[1]); }

__device__ __forceinline__ float max3f(float a, float b, float c) { float r; asm("v_max3_f32 %0, %1, %2, %3" : "=v"(r) : "v"(a), "v"(b), "v"(c)); return r; }
__device__ __forceinline__ float fadd_s(float a, float b) { float r; asm("v_add_f32_e32 %0, %1, %2" : "=v"(r) : "v"(a), "v"(b)); return r; }
constexpr float ATT_THR = 10.0f;
__device__ __forceinline__ void softmax_pv(f32x16& p0, f32x16& p1, float& mhat, float& l, bool& started, f32x16 (&o)[2], const LAS unsigned char* vb) {
    float a = max3f(p0[0], p0[1], p1[0]), b = max3f(p0[2], p0[3], p1[1]); a = max3f(a, p1[2], p1[3]);
#pragma unroll
    for (int r = 4; r < 16; r += 4) { a = max3f(a, p0[r], p0[r + 1]); b = max3f(b, p0[r + 2], p0[r + 3]); a = max3f(a, p1[r], p1[r + 1]); b = max3f(b, p1[r + 2], p1[r + 3]); }
    const float rm = swap_max(fmaxf(a, b));
    if (!started) {
        mhat = rm; started = true;
#pragma unroll
        for (int r = 0; r < 16; ++r) { p0[r] -= rm; p1[r] -= rm; }
    } else if (__any(rm > ATT_THR)) {
        const float dl = fmaxf(rm, 0.f); mhat += dl;
        const float f = __builtin_amdgcn_exp2f(-dl); l *= f;
#pragma unroll
        for (int r = 0; r < 16; ++r) { p0[r] -= dl; p1[r] -= dl; o[0][r] *= f; o[1][r] *= f; }
    }
    float s0 = 0.f, s1 = 0.f;
#pragma unroll
    for (int r = 0; r < 16; ++r) { p0[r] = __builtin_amdgcn_exp2f(p0[r]); p1[r] = __builtin_amdgcn_exp2f(p1[r]); }
    asm volatile("s_nop 0" : "+v"(p0), "+v"(p1));
#pragma unroll
    for (int r = 0; r < 16; ++r) { s0 = fadd_s(s0, p0[r]); s1 = fadd_s(s1, p1[r]); }
    l += s0 + s1;
    u32x4 pw[4];
    pw[0] = (u32x4){cvtpk(p0[0], p0[1]), cvtpk(p0[2], p0[3]), cvtpk(p0[4], p0[5]), cvtpk(p0[6], p0[7])};
    pw[1] = (u32x4){cvtpk(p0[8], p0[9]), cvtpk(p0[10], p0[11]), cvtpk(p0[12], p0[13]), cvtpk(p0[14], p0[15])};
    pw[2] = (u32x4){cvtpk(p1[0], p1[1]), cvtpk(p1[2], p1[3]), cvtpk(p1[4], p1[5]), cvtpk(p1[6], p1[7])};
    pw[3] = (u32x4){cvtpk(p1[8], p1[9]), cvtpk(p1[10], p1[11]), cvtpk(p1[12], p1[13]), cvtpk(p1[14], p1[15])};
#pragma unroll
    for (int dt = 0; dt < 2; ++dt)
#pragma unroll
        for (int ks = 0; ks < 4; ++ks) {
            const v4i16_t lo = tr_read(vb + dt * 4096 + ks * 1024), hi4 = tr_read(vb + dt * 4096 + ks * 1024 + 512);
            const bf16x8 vf = (bf16x8){lo[0], lo[1], lo[2], lo[3], hi4[0], hi4[1], hi4[2], hi4[3]};
            o[dt] = __builtin_amdgcn_mfma_f32_32x32x16_bf16(vf, __builtin_bit_cast(bf16x8, pw[ks]), o[dt], 0, 0, 0);
        }
}

template <bool DIFF>
__device__ __forceinline__ void attn_unit(LAS unsigned char* lds, const bf16_t* proj, const float* Cs, bf16_t* Ymix, int b, int h, int qb, float lam, float onemli, const float* dng) {
    int tid_ = threadIdx.x; asm volatile("" : "+v"(tid_)); const int tid = tid_, lane = tid & 63, r32 = lane & 31, hi = lane >> 5, wid = __builtin_amdgcn_readfirstlane(tid >> 6);
    const size_t rowbase = (size_t)b * SEQ;
    const int q0w = qb * 256 + wid * 32, qpos = q0w + r32;
    const int qcol = (DIFF ? PJ_DQ : PJ_FQ) + h * 64, kcol = (DIFF ? PJ_DK : PJ_FK) + h * 64, vcol = (DIFF ? PJ_DV : PJ_FV) + h * 64, ocol = (DIFF ? 384 : 0) + h * 64;
    bf16x8 qr[4];
#pragma unroll
    for (int d0 = 0; d0 < 4; ++d0) qr[d0] = *(const bf16x8*)(proj + (rowbase + qpos) * NPROJ + qcol + d0 * 16 + hi * 8);
    const float* Crow = Cs + (size_t)(b * FOXH + h) * SEQ;
    float cq = 0.f, sl2 = 0.f;
    if (!DIFF) cq = Crow[qpos]; else sl2 = exp2f(-2.0f * (float)(h + 1)) * LOG2E;
    float m0 = 0.f, l0 = 0.f, m1 = 0.f, l1 = 0.f; bool st0 = false, st1 = false;
    f32x16 oa[2], ob[2];
    oa[0] = f32x16{}; oa[1] = f32x16{}; ob[0] = f32x16{}; ob[1] = f32x16{};
    const int NT = 4 * (qb + 1);
    const int krow = 8 * wid + (lane >> 3);
    const bf16_t* kg = proj + (rowbase + krow) * NPROJ + kcol + (((lane & 7) ^ ((krow >> 1) & 7)) * 8);
    const bf16_t* vg = proj + (rowbase + 16 * (wid & 3) + (lane >> 2)) * NPROJ + vcol + ((wid >> 2) * 4 + (lane & 3)) * 8;
    const float* cgp = Crow + lane;
#define ATT_ISSUE(it_) do { const int t_ = NT - 1 - (it_), sl_ = (it_) & 3; const size_t go_ = (size_t)t_ * 64 * NPROJ; \
        if (!DIFF) __builtin_amdgcn_global_load_lds((const unsigned*)(cgp + t_ * 64), (LAS unsigned*)(lds + AC_OFF + sl_ * AC_BUF), 4, 0, 0); \
        __builtin_amdgcn_global_load_lds((const unsigned*)(kg + go_), (LAS unsigned*)(lds + AK_OFF + sl_ * AK_BUF + wid * 1024), 16, 0, 0); \
        __builtin_amdgcn_global_load_lds((const unsigned*)(vg + go_), (LAS unsigned*)(lds + AV_OFF + sl_ * AV_BUF + wid * 1024), 16, 0, 0); } while (0)
#define ATT_WAIT(n) asm volatile("s_waitcnt vmcnt(" #n ")" ::: "memory")
    ATT_ISSUE(0); ATT_ISSUE(1); ATT_ISSUE(2);
    int koff[4];
#pragma unroll
    for (int d0 = 0; d0 < 4; ++d0) koff[d0] = AK_OFF + r32 * 128 + (((2 * d0 + hi) ^ ((r32 >> 1) & 7)) << 4);
    const LAS unsigned char* vb0 = lds + AV_OFF + (4 * hi + ((lane & 15) >> 2)) * 64 + ((lane >> 4) & 1) * 32 + (lane & 3) * 8;
    for (int it = 0; it < NT; ++it) {
        const int t = NT - 1 - it, sl = it & 3, kv0 = t * 64;
        if (t >= 2) { if (DIFF) ATT_WAIT(4); else ATT_WAIT(6); } else if (t == 1) { if (DIFF) ATT_WAIT(2); else ATT_WAIT(3); } else ATT_WAIT(0);
        __builtin_amdgcn_s_barrier(); asm volatile("" ::: "memory");
        if (it + 3 < NT) ATT_ISSUE(it + 3);
        if (kv0 <= q0w + 31) {
            const bool need_mask = (kv0 + 63 > q0w);
            const LAS unsigned char* kb = lds + sl * AK_BUF;
            const LAS unsigned char* vb = vb0 + sl * AV_BUF;
            if (!DIFF) {
                f32x16 p0, p1;
                const LAS float* ck = (const LAS float*)(lds + AC_OFF + sl * AC_BUF); const float cqm = cq - m0;
#pragma unroll
                for (int g = 0; g < 4; ++g) {
                    const f32x4 c0 = *(const LAS f32x4*)(ck + 8 * g + 4 * hi), c1 = *(const LAS f32x4*)(ck + 32 + 8 * g + 4 * hi);
#pragma unroll
                    for (int j = 0; j < 4; ++j) { p0[4 * g + j] = cqm - c0[j]; p1[4 * g + j] = cqm - c1[j]; }
                }
#pragma unroll
                for (int d0 = 0; d0 < 4; ++d0) {
                    const bf16x8 k0 = *(const LAS bf16x8*)(kb + koff[d0]), k1 = *(const LAS bf16x8*)(kb + koff[d0] + 4096);
                    p0 = __builtin_amdgcn_mfma_f32_32x32x16_bf16(k0, qr[d0], p0, 0, 0, 0);
                    p1 = __builtin_amdgcn_mfma_f32_32x32x16_bf16(k1, qr[d0], p1, 0, 0, 0);
                }
                asm volatile("s_nop 15\n\ts_nop 7" : "+v"(p0), "+v"(p1));
                if (need_mask) {
#pragma unroll
                    for (int r = 0; r < 16; ++r) { const int kv = kv0 + (r & 3) + 8 * (r >> 2) + 4 * hi; if (kv > qpos) p0[r] = -INFINITY; if (kv + 32 > qpos) p1[r] = -INFINITY; }
                }
                softmax_pv(p0, p1, m0, l0, st0, oa, vb);
            } else {
#pragma unroll
                for (int mp = 0; mp < 2; ++mp) {
                    f32x16 p0, p1;
                    const float bq = sl2 * (float)(kv0 + 4 * hi - qpos) - (mp == 0 ? m0 : m1);
#pragma unroll
                    for (int r = 0; r < 16; ++r) { const float off = (float)((r & 3) + 8 * (r >> 2)); p0[r] = fmaf(sl2, off, bq); p1[r] = fmaf(sl2, off + 32.f, bq); }
#pragma unroll
                    for (int d0 = 0; d0 < 2; ++d0) {
                        const bf16x8 k0 = *(const LAS bf16x8*)(kb + koff[2 * mp + d0]), k1 = *(const LAS bf16x8*)(kb + koff[2 * mp + d0] + 4096);
                        p0 = __builtin_amdgcn_mfma_f32_32x32x16_bf16(k0, qr[2 * mp + d0], p0, 0, 0, 0);
                        p1 = __builtin_amdgcn_mfma_f32_32x32x16_bf16(k1, qr[2 * mp + d0], p1, 0, 0, 0);
                    }
                    asm volatile("s_nop 15\n\ts_nop 7" : "+v"(p0), "+v"(p1));
                    if (need_mask) {
#pragma unroll
                        for (int r = 0; r < 16; ++r) { const int kv = kv0 + (r & 3) + 8 * (r >> 2) + 4 * hi; if (kv > qpos) p0[r] = -INFINITY; if (kv + 32 > qpos) p1[r] = -INFINITY; }
                    }
                    if (mp == 0) softmax_pv(p0, p1, m0, l0, st0, oa, vb); else softmax_pv(p0, p1, m1, l1, st1, ob, vb);
                }
            }
        }
        asm volatile("s_waitcnt lgkmcnt(0)" ::: "memory");
    }
#undef ATT_ISSUE
#undef ATT_WAIT
    bf16_t* orow = Ymix + (rowbase + qpos) * DM + ocol;
    if (!DIFF) {
        const float inv = 1.0f / swap_sum(l0);
#pragma unroll
        for (int dt = 0; dt < 2; ++dt)
#pragma unroll
            for (int g = 0; g < 4; ++g) {
                u32x2 w; w.x = cvtpk(oa[dt][4 * g] * inv, oa[dt][4 * g + 1] * inv); w.y = cvtpk(oa[dt][4 * g + 2] * inv, oa[dt][4 * g + 3] * inv);
                *(u32x2*)(orow + 32 * dt + 8 * g + 4 * hi) = w;
            }
    } else {
        const float i0 = 1.0f / swap_sum(l0), i1 = lam / swap_sum(l1);
        float ss = 0.f;
#pragma unroll
        for (int dt = 0; dt < 2; ++dt)
#pragma unroll
            for (int r = 0; r < 16; ++r) { const float x = oa[dt][r] * i0 - ob[dt][r] * i1; oa[dt][r] = x; ss += x * x; }
        ss = swap_sum(ss);
        const float rs = (1.0f / sqrtf(ss * (1.0f / 64.0f) + LN_EPS)) * onemli;
#pragma unroll
        for (int dt = 0; dt < 2; ++dt)
#pragma unroll
            for (int g = 0; g < 4; ++g) {
                const f32x4 gg = *(const f32x4*)(dng + h * 64 + 32 * dt + 8 * g + 4 * hi);
                u32x2 w; w.x = cvtpk(oa[dt][4 * g] * rs * gg[0], oa[dt][4 * g + 1] * rs * gg[1]); w.y = cvtpk(oa[dt][4 * g + 2] * rs * gg[2], oa[dt][4 * g + 3] * rs * gg[3]);
                *(u32x2*)(orow + 32 * dt + 8 * g + 4 * hi) = w;
            }
    }
}

__device__ __forceinline__ void sgu_unit(LAS unsigned char* lds, const bf16_t* proj, bf16_t* Ymix, size_t tok0, const bf16_t* wsg, const float* lng, const float* lnb, const float* bs) {
    int tid_ = threadIdx.x; asm volatile("" : "+v"(tid_)); const int tid = tid_, lane = tid & 63, r32 = lane & 31, hi = lane >> 5, wid = __builtin_amdgcn_readfirstlane(tid >> 6);
    {
        const int row = tid >> 2, part = tid & 3;
        const bf16_t* src = proj + (tok0 + row) * NPROJ + PJ_SG + part * 96;
        u32x4 ch[12]; float s = 0.f, s2 = 0.f;
#pragma unroll
        for (int c = 0; c < 12; ++c) {
            ch[c] = *(const u32x4*)(src + c * 8);
#pragma unroll
            for (int j = 0; j < 4; ++j) { const unsigned w = ch[c][j]; const float a = __uint_as_float(w << 16), bq = __uint_as_float(w & 0xffff0000u); s += a + bq; s2 += a * a + bq * bq; }
        }
        s += __shfl_xor(s, 1); s += __shfl_xor(s, 2); s2 += __shfl_xor(s2, 1); s2 += __shfl_xor(s2, 2);
        const float mean = s * (1.0f / 384.0f); const float var = fmaxf(s2 * (1.0f / 384.0f) - mean * mean, 0.f);
        const float rstd = 1.0f / sqrtf(var + LN_EPS);
#pragma unroll
        for (int c = 0; c < 12; ++c) {
            const int col = part * 96 + c * 8;
            const f32x4 g0 = *(const f32x4*)(lng + col), g1 = *(const f32x4*)(lng + col + 4), b0 = *(const f32x4*)(lnb + col), b1 = *(const f32x4*)(lnb + col + 4);
            float v[8];
#pragma unroll
            for (int j = 0; j < 4; ++j) { const unsigned w = ch[c][j]; v[2 * j] = __uint_as_float(w << 16); v[2 * j + 1] = __uint_as_float(w & 0xffff0000u); }
            u32x4 o;
            o.x = cvtpk((v[0] - mean) * rstd * g0[0] + b0[0], (v[1] - mean) * rstd * g0[1] + b0[1]);
            o.y = cvtpk((v[2] - mean) * rstd * g0[2] + b0[2], (v[3] - mean) * rstd * g0[3] + b0[3]);
            o.z = cvtpk((v[4] - mean) * rstd * g1[0] + b1[0], (v[5] - mean) * rstd * g1[1] + b1[1]);
            o.w = cvtpk((v[6] - mean) * rstd * g1[2] + b1[2], (v[7] - mean) * rstd * g1[3] + b1[3]);
            *(LAS u32x4*)(lds + (col >> 5) * 8192 + row * 64 + (col & 31) * 2) = o;
        }
    }
    __syncthreads();
    const int tt = wid & 3, dt = wid >> 2;
    const LAS unsigned char* gb0 = lds + (8 * hi + ((lane & 15) >> 2)) * 64 + ((lane >> 4) & 1) * 32 + (lane & 3) * 8;
    const int trow = 32 * tt + r32;
    for (int hh = 0; hh < SGUH; ++hh) {
        f32x16 acc = f32x16{};
        const bf16_t* wrow = wsg + ((size_t)hh * 128 + trow) * 128 + 8 * hi;
        const LAS unsigned char* gb = gb0 + (2 * hh + dt) * 8192;
        bf16x8 wf[8];
#pragma unroll
        for (int ks = 0; ks < 8; ++ks) wf[ks] = (ks < 2 * (tt + 1)) ? *(const bf16x8*)(wrow + 16 * ks) : (bf16x8){0, 0, 0, 0, 0, 0, 0, 0};
#pragma unroll
        for (int ks = 0; ks < 8; ++ks) {
            if (ks < 2 * (tt + 1)) {
                const v4i16_t lo = tr_read(gb + ks * 1024), hi4 = tr_read(gb + ks * 1024 + 256);
                const bf16x8 gf = (bf16x8){lo[0], lo[1], lo[2], lo[3], hi4[0], hi4[1], hi4[2], hi4[3]};
                acc = __builtin_amdgcn_mfma_f32_32x32x16_bf16(gf, wf[ks], acc, 0, 0, 0);
            }
        }
        const float bsv = bs[hh * 128 + trow];
        const bf16_t* up = proj + (tok0 + trow) * NPROJ + PJ_SU + hh * 64 + 32 * dt + 4 * hi;
        bf16_t* op = Ymix + (tok0 + trow) * DM + 640 + hh * 64 + 32 * dt + 4 * hi;
#pragma unroll
        for (int g = 0; g < 4; ++g) {
            const u32x2 uu = *(const u32x2*)(up + 8 * g);
            const float u0 = __uint_as_float(uu.x << 16), u1 = __uint_as_float(uu.x & 0xffff0000u), u2 = __uint_as_float(uu.y << 16), u3 = __uint_as_float(uu.y & 0xffff0000u);
            u32x2 w; w.x = cvtpk(u0 * (acc[4 * g] + bsv), u1 * (acc[4 * g + 1] + bsv)); w.y = cvtpk(u2 * (acc[4 * g + 2] + bsv), u3 * (acc[4 * g + 3] + bsv));
            *(u32x2*)(op + 8 * g) = w;
        }
    }
    __syncthreads();
}

constexpr int N_ATT_UNITS = 16 * 80, N_SGU_UNITS = BATCH * (SEQ / 128), N_MIX_UNITS = N_ATT_UNITS + N_SGU_UNITS;
__device__ __forceinline__ void mixer_phase(PP p, LAS unsigned char* lds, int l) {
    unsigned char* ws = p->ws;
    unsigned* ctl = (unsigned*)(ws + WS_CTL);
    const bf16_t* proj = (const bf16_t*)(ws + WS_HID); bf16_t* Ymix = (bf16_t*)(ws + WS_YMIX); const float* Cs = (const float*)(ws + WS_C);
    const float lam = ((const float*)ctl)[32 + 2 * l], onemli = ((const float*)ctl)[33 + 2 * l];
    volatile LAS unsigned* sw = (volatile LAS unsigned*)(lds + LDS_SCHED);
    for (;;) {
        if (threadIdx.x == 0) sw[0] = atomicAdd(ctl + l, 1u);
        __syncthreads();
        const unsigned u = sw[0];
        __syncthreads();
        if (u >= (unsigned)N_MIX_UNITS) break;
        if (u >= (unsigned)N_SGU_UNITS) {
            const unsigned ua = u - N_SGU_UNITS; const int qb = 15 - (int)(ua / 80u), j = (int)(ua % 80u);
            if (j < 32) attn_unit<true>(lds, proj, Cs, Ymix, j >> 2, j & 3, qb, lam, onemli, p->diff_norm_g + l * 256);
            else { const int bh = j - 32; attn_unit<false>(lds, proj, Cs, Ymix, bh / FOXH, bh % FOXH, qb, 0.f, 0.f, nullptr); }
        } else {
            const int c = (int)u;
            sgu_unit(lds, proj, Ymix, (size_t)c * 128, (const bf16_t*)(ws + WS_WSG) + (size_t)l * 6 * 128 * 128, p->sgu_ng + l * 384, p->sgu_nb + l * 384, p->sgu_b + l * 768);
        }
    }
}
template <class Epi>
__device__ __forceinline__ void run_gemm(LAS unsigned char* lds, const bf16_t* A, const bf16_t* Bt, int N, int K, const Epi& E, int G) {
    pg8::Gemm g{A, Bt, T, N, K}; pg8::StaticOrder S; S.init(T, N, G, (int)blockIdx.x);
    pg8::gemm_phase<Epi, pg8::StaticOrder, true, true>(lds, g, S, E);
}

__global__ void __launch_bounds__(512, 2) fwd_megakernel(Params p) {
    extern __shared__ __attribute__((aligned(16))) unsigned char lds_raw[];
    LAS unsigned char* lds = (LAS unsigned char*)lds_raw;
    cg::grid_group grid = cg::this_grid();
#define PARG() parg()
#define GSZ() ((int)gridDim.x)
#define WGU(q, l, ab) ((const bf16_t*)((q)->ws + WS_WGU) + (size_t)((l) * 2 + (ab)) * NGU * DM)
#define WDN(q, l, ab) ((const bf16_t*)((q)->ws + WS_WD) + (size_t)((l) * 2 + (ab)) * DM * FF)
    prologue(PARG(), lds, GSZ());
    grid.sync();
#pragma nounroll
    for (int l = 0; l < DEPTH; ++l) {
        { PP q = PARG(); EpiSwiGLU E{(bf16_t*)(q->ws + WS_HID)}; run_gemm(lds, (const bf16_t*)(q->ws + WS_HB), WGU(q, l, 0), NGU, DM, E, GSZ()); }
        grid.sync();
        { PP q = PARG(); EpiResid E{l == 0 ? q->x : q->out, q->out, ALPHA, 0.5f}; run_gemm(lds, (const bf16_t*)(q->ws + WS_HID), WDN(q, l, 0), DM, FF, E, GSZ()); }
        grid.sync();
        { PP q = PARG(); ln_phase(q->out, (bf16_t*)(q->ws + WS_HB), q->norm_a_g + l * DM, q->norm_a_b + l * DM, GSZ()); }
        grid.sync();
        { PP q = PARG(); EpiProj E{(bf16_t*)(q->ws + WS_HID), (float*)(q->ws + WS_LF), q->f_bias + l * FOXH};
          run_gemm(lds, (const bf16_t*)(q->ws + WS_HB), (const bf16_t*)(q->ws + WS_WIN) + (size_t)l * NPROJ * DM, NPROJ, DM, E, GSZ()); }
        grid.sync();
        { PP q = PARG(); scan_phase((const float*)(q->ws + WS_LF), (float*)(q->ws + WS_C), lds, GSZ()); }
        grid.sync();
        mixer_phase(PARG(), lds, l);
        grid.sync();
        { PP q = PARG(); EpiResid E{q->out, q->out, ALPHA, 1.0f}; run_gemm(lds, (const bf16_t*)(q->ws + WS_YMIX), (const bf16_t*)(q->ws + WS_WOUT) + (size_t)l * DM * DM, DM, DM, E, GSZ()); }
        grid.sync();
        { PP q = PARG(); ln_phase(q->out, (bf16_t*)(q->ws + WS_HB), q->norm_m_g + l * DM, q->norm_m_b + l * DM, GSZ()); }
        grid.sync();
        { PP q = PARG(); EpiSwiGLU E{(bf16_t*)(q->ws + WS_HID)}; run_gemm(lds, (const bf16_t*)(q->ws + WS_HB), WGU(q, l, 1), NGU, DM, E, GSZ()); }
        grid.sync();
        { PP q = PARG(); EpiResid E{q->out, q->out, ALPHA, 0.5f}; run_gemm(lds, (const bf16_t*)(q->ws + WS_HID), WDN(q, l, 1), DM, FF, E, GSZ()); }
        grid.sync();
        { PP q = PARG(); ln_phase(q->out, (bf16_t*)(q->ws + WS_HB), q->norm_b_g + l * DM, q->norm_b_b + l * DM, GSZ()); }
        if (l + 1 < DEPTH) grid.sync();
    }
}

extern "C" void kernel_launch(void* const* d_in, const int* in_sizes, int n_in, void* d_out, int out_size, void* d_ws, size_t ws_size, hipStream_t stream) {
    static int grid_blocks = 0;
    if (grid_blocks == 0) {
        if (n_in != 25 || in_sizes[0] != T * DM || out_size != T * DM || ws_size < WS_END) { fprintf(stderr, "kernel_launch: unexpected shapes (n_in %d, in0 %d, out %d, ws %zu)\n", n_in, n_in > 0 ? in_sizes[0] : -1, out_size, ws_size); grid_blocks = -1; return; }
        int dev = 0, cus = 0, per_cu = 0;
        hipGetDevice(&dev);
        hipDeviceGetAttribute(&cus, hipDeviceAttributeMultiprocessorCount, dev);
        if (hipFuncSetAttribute((const void*)fwd_megakernel, hipFuncAttributeMaxDynamicSharedMemorySize, LDS_BYTES) != hipSuccess) { fprintf(stderr, "kernel_launch: hipFuncSetAttribute failed\n"); }
        if (hipOccupancyMaxActiveBlocksPerMultiprocessor(&per_cu, (const void*)fwd_megakernel, 512, LDS_BYTES) != hipSuccess || per_cu < 1) { fprintf(stderr, "kernel_launch: occupancy query gave %d\n", per_cu); per_cu = 1; }
        (void)hipGetLastError();
        grid_blocks = cus * per_cu;
    }
    if (grid_blocks < 0) return;
    Params p{};
    const float** pp = (const float**)&p;
    for (int i = 0; i < 25; ++i) pp[i] = (const float*)d_in[i];
    p.out = (float*)d_out; p.ws = (unsigned char*)d_ws;
    void* args[] = {&p};
    hipError_t e = hipLaunchCooperativeKernel((const void*)fwd_megakernel, dim3(grid_blocks), dim3(512), args, LDS_BYTES, stream);
    if (e != hipSuccess) fprintf(stderr, "cooperative launch failed: %s (grid %d)\n", hipGetErrorString(e), grid_blocks);
}
```
